# Optimizing an MI355X kernel written in HIP

```python
import jax, jax.numpy as jnp
from jax import lax
import numpy as np

D_MODEL = 1024
BATCH = 8
SEQ = 8192
DEPTH = 1

D_RNN = 1024
RNN_BLOCKS = 8
RNN_BLOCK_W = D_RNN // RNN_BLOCKS
CONV_W = 4
LRU_C = 8.0
N_HEADS = 8
HEAD_DIM = 128
D_ATTN = N_HEADS * HEAD_DIM
ROT_DIM = HEAD_DIM // 4
ROPE_THETA = 500000.0
DILATED_GROUPS = ((128, 1), (512, 4), (2048, 16))
NEG_INF = -1e30
IN_WIDTHS = (D_RNN, D_RNN, D_ATTN, D_ATTN, D_ATTN, D_ATTN, D_MODEL, D_MODEL)
D_IN = sum(IN_WIDTHS)
IN_SPLITS = [int(s) for s in np.cumsum(IN_WIDTHS)[:-1]]
NORM_EPS = 1e-6

kernel_name = "hybrid_rglru_dilated_attn_block"


def rms_norm(x, g):
    xf = x.astype(jnp.float32)
    y = xf * lax.rsqrt(jnp.mean(xf * xf, axis=-1, keepdims=True) + NORM_EPS)
    return (y * g.astype(jnp.float32)).astype(x.dtype)


def causal_depthwise_conv(x, w, b):
    y = lax.conv_general_dilated(
        x, w[:, None, :], window_strides=(1,), padding=[(CONV_W - 1, 0)],
        dimension_numbers=("NWC", "WIO", "NWC"), feature_group_count=x.shape[-1])
    return y + b


def rg_lru(x, w_a, b_a, w_x, b_x, lam, positions):
    B, S, _ = x.shape
    xf = x.astype(jnp.float32)
    xh = xf.reshape(B, S, RNN_BLOCKS, RNN_BLOCK_W)
    r = jax.nn.sigmoid(jnp.einsum("bshi,hij->bshj", xh, w_a.astype(jnp.float32)) + b_a.astype(jnp.float32))
    i = jax.nn.sigmoid(jnp.einsum("bshi,hij->bshj", xh, w_x.astype(jnp.float32)) + b_x.astype(jnp.float32))
    r = r.reshape(B, S, D_RNN)
    i = i.reshape(B, S, D_RNN)
    log_a = -LRU_C * r * jax.nn.softplus(-lam.astype(jnp.float32))
    reset = (positions == 0)[..., None]
    a = jnp.where(reset, 0.0, jnp.exp(log_a))
    mult = jnp.where(reset, 1.0, jnp.sqrt(-jnp.expm1(2.0 * log_a)))
    bx = mult * i * xf

    def combine(left, right):
        a1, b1 = left
        a2, b2 = right
        return a1 * a2, a2 * b1 + b2

    _, h = lax.associative_scan(combine, (a, bx), axis=1)
    return h


def apply_partial_rope(t, cos, sin):
    tf = t.astype(jnp.float32)
    half = ROT_DIM // 2
    x1 = tf[..., :half]
    x2 = tf[..., half:ROT_DIM]
    return jnp.concatenate([x1 * cos - x2 * sin, x2 * cos + x1 * sin, tf[..., ROT_DIM:]], axis=-1)


def dilated_window_attention(q, k, v, window, dilation):
    B, S, H, Dh = q.shape
    blk = window // dilation
    span = blk * dilation
    s_pad = -(-S // span) * span
    nb = s_pad // span

    def to_blocks(t):
        t = jnp.pad(t, ((0, 0), (0, s_pad - S), (0, 0), (0, 0)))
        return t.reshape(B, nb, blk, dilation, H, Dh)

    qb, kb, vb = to_blocks(q), to_blocks(k), to_blocks(v)
    pad_prev = ((0, 0), (1, 0), (0, 0), (0, 0), (0, 0), (0, 0))
    kk = jnp.concatenate([jnp.pad(kb[:, :-1], pad_prev), kb], axis=2)
    vv = jnp.concatenate([jnp.pad(vb[:, :-1], pad_prev), vb], axis=2)
    s = jnp.einsum("bnqrhd,bnkrhd->bnrhqk", qb, kk) * (HEAD_DIM ** -0.5)
    qi = jnp.arange(blk)[:, None]
    ki = jnp.arange(2 * blk)[None, :]
    dist = blk + qi - ki
    band = (dist >= 0) & (dist <= blk)
    n_idx = jnp.arange(nb)[:, None, None]
    valid = band[None] & ((n_idx > 0) | (ki[None] >= blk))
    s = jnp.where(valid[None, :, None, None], s, NEG_INF)
    lse = jax.nn.logsumexp(s, axis=-1)
    p = jnp.exp(s - lse[..., None])
    o = jnp.einsum("bnrhqk,bnkrhd->bnqrhd", p, vv)
    o = o.reshape(B, s_pad, H, Dh)[:, :S]
    lse = lse.transpose(0, 1, 4, 2, 3).reshape(B, s_pad, H)[:, :S]
    return o, lse


def dilated_attention_mixture(q, k, v):
    outs, lses = [], []
    for window, dilation in DILATED_GROUPS:
        o, l = dilated_window_attention(q, k, v, window, dilation)
        outs.append(o)
        lses.append(l)
    w = jax.nn.softmax(jnp.stack(lses, axis=0), axis=0)
    return jnp.einsum("gbsh,gbshd->bshd", w, jnp.stack(outs, axis=0))


def setup_inputs(seed: int = 0) -> dict:
    key = jax.random.key(seed)
    ks = jax.random.split(key, 20)
    f32 = jnp.float32
    nrm = lambda k, shape, scale: jax.random.normal(k, shape, f32) * scale
    x = jax.random.normal(ks[0], (BATCH, SEQ, D_MODEL), f32)
    c = jax.random.normal(ks[1], (BATCH, D_MODEL), f32)
    positions = jnp.broadcast_to(jnp.arange(SEQ, dtype=jnp.int32)[None, :], (BATCH, SEQ))
    g_norm = 1.0 + nrm(ks[2], (DEPTH, D_MODEL), 0.02)
    w_mod = nrm(ks[3], (DEPTH, D_MODEL, 3 * D_MODEL), 0.5 * D_MODEL ** -0.5)
    b_mod = nrm(ks[4], (DEPTH, 3 * D_MODEL), 0.01)
    w_in = nrm(ks[5], (DEPTH, D_MODEL, D_IN), D_MODEL ** -0.5)
    b_gate = nrm(ks[6], (DEPTH, 2 * D_MODEL), 0.01)
    conv_w = nrm(ks[7], (DEPTH, CONV_W, D_RNN), CONV_W ** -0.5)
    conv_b = nrm(ks[8], (DEPTH, D_RNN), 0.01)
    w_a = nrm(ks[9], (DEPTH, RNN_BLOCKS, RNN_BLOCK_W, RNN_BLOCK_W), RNN_BLOCK_W ** -0.5)
    b_a = nrm(ks[10], (DEPTH, RNN_BLOCKS, RNN_BLOCK_W), 0.01)
    w_x = nrm(ks[11], (DEPTH, RNN_BLOCKS, RNN_BLOCK_W, RNN_BLOCK_W), RNN_BLOCK_W ** -0.5)
    b_x = nrm(ks[12], (DEPTH, RNN_BLOCKS, RNN_BLOCK_W), 0.01)
    a0 = jax.random.uniform(ks[13], (DEPTH, D_RNN), f32, 0.9, 0.999)
    sig = a0 ** (1.0 / LRU_C)
    lam = jnp.log(sig) - jnp.log1p(-sig)
    w_out_rnn = nrm(ks[14], (DEPTH, D_RNN, D_MODEL), D_RNN ** -0.5)
    w_out_attn = nrm(ks[15], (DEPTH, D_ATTN, D_MODEL), D_ATTN ** -0.5)
    w_o = nrm(ks[16], (DEPTH, D_MODEL, D_MODEL), D_MODEL ** -0.5)
    g_final = 1.0 + nrm(ks[17], (D_MODEL,), 0.02)
    return {"x": x, "c": c, "positions": positions, "g_norm": g_norm, "w_mod": w_mod,
            "b_mod": b_mod, "w_in": w_in, "b_gate": b_gate, "conv_w": conv_w, "conv_b": conv_b,
            "w_a": w_a, "b_a": b_a, "w_x": w_x, "b_x": b_x, "lam": lam, "w_out_rnn": w_out_rnn,
            "w_out_attn": w_out_attn, "w_o": w_o, "g_final": g_final}


def reference(x, c, positions, g_norm, w_mod, b_mod, w_in, b_gate, conv_w, conv_b,
              w_a, b_a, w_x, b_x, lam, w_out_rnn, w_out_attn, w_o, g_final):
    B, S, _ = x.shape
    dt = x.dtype
    inv_freq = ROPE_THETA ** (-jnp.arange(0, ROT_DIM, 2, dtype=jnp.float32) / ROT_DIM)
    ang = positions.astype(jnp.float32)[..., None] * inv_freq
    cos = jnp.cos(ang)[:, :, None, :]
    sin = jnp.sin(ang)[:, :, None, :]
    c_act = jax.nn.silu(c)
    for l in range(DEPTH):
        mod = c_act @ w_mod[l] + b_mod[l]
        shift, scale, gate = jnp.split(mod, 3, axis=-1)
        h = rms_norm(x, g_norm[l]) * (1.0 + scale[:, None, :]) + shift[:, None, :]
        proj = h @ w_in[l]
        x_rnn, z_rnn, q, k, v, z_attn, g_r, g_a = jnp.split(proj, IN_SPLITS, axis=-1)
        xc = causal_depthwise_conv(x_rnn, conv_w[l], conv_b[l])
        hr = rg_lru(xc, w_a[l], b_a[l], w_x[l], b_x[l], lam[l], positions)
        y_rnn = (hr * jax.nn.silu(z_rnn.astype(jnp.float32))).astype(dt) @ w_out_rnn[l]
        qh = apply_partial_rope(q.reshape(B, S, N_HEADS, HEAD_DIM), cos, sin)
        kh = apply_partial_rope(k.reshape(B, S, N_HEADS, HEAD_DIM), cos, sin)
        vh = v.reshape(B, S, N_HEADS, HEAD_DIM).astype(jnp.float32)
        o = dilated_attention_mixture(qh, kh, vh).reshape(B, S, D_ATTN)
        y_attn = (o * jax.nn.silu(z_attn.astype(jnp.float32))).astype(dt) @ w_out_attn[l]
        bg_r, bg_a = jnp.split(b_gate[l], 2, axis=-1)
        merged = jax.nn.sigmoid(g_r + bg_r) * y_rnn + jax.nn.sigmoid(g_a + bg_a) * y_attn
        x = x + gate[:, None, :] * (merged @ w_o[l])
    return rms_norm(x, g_final)
```

```cpp
#include <hip/hip_runtime.h>
#include <hip/hip_bf16.h>
#include <cstdio>
#include <cstdint>
#include <cmath>

typedef unsigned short bf16_t;
#define DI __device__ __forceinline__

constexpr int D = 1024, BATCH = 8, SEQ = 8192, M = BATCH * SEQ;
constexpr int NP = 6144;
constexpr int C_XR = 0, C_Q = 1024, C_K = 2048, C_V = 3072, C_ZR = 4096, C_ZA = 5120;
constexpr float QSCALE = 0.08838834764831845f * 1.4426950408889634f;
constexpr float LOG2E = 1.4426950408889634f;

constexpr size_t OFF_P6 = 0;
constexpr size_t OFF_H = OFF_P6 + (size_t)M * NP * 2;
constexpr size_t OFF_WINT = OFF_H + (size_t)M * D * 2;
constexpr size_t OFF_WGL = OFF_WINT + (size_t)6144 * 1024 * 2;
constexpr size_t OFF_WR = OFF_WGL + (size_t)2048 * 1024 * 2;
constexpr size_t OFF_WA = OFF_WR + (size_t)1024 * 1024 * 2;
constexpr size_t OFF_WO = OFF_WA + (size_t)1024 * 1024 * 2;
constexpr size_t OFF_WGT = OFF_WO + (size_t)1024 * 1024 * 2;
constexpr size_t OFF_MOD = OFF_WGT + (size_t)8 * 256 * 128 * 2;
constexpr size_t OFF_SP = OFF_MOD + 131072;
constexpr size_t OFF_ROPE = OFF_SP + 4096;
constexpr size_t OFF_SUM = OFF_ROPE + (size_t)M * 16 * 8;
constexpr size_t OFF_LSE = OFF_SUM + (size_t)2 * 8 * 64 * 1024 * 4;
constexpr size_t OFF_ROWSQ = OFF_LSE + (size_t)2 * M * 8 * 4;
constexpr size_t OFF_GSCR = OFF_ROWSQ + (size_t)M * 4 * 4;
constexpr size_t OFF_END = OFF_GSCR + (size_t)256 * 262144;

struct Params {
    const float* x; const float* c; const int* pos; const float* g_norm; const float* w_mod; const float* b_mod;
    const float* w_in; const float* b_gate; const float* conv_w; const float* conv_b; const float* w_a; const float* b_a;
    const float* w_x; const float* b_x; const float* lam; const float* w_out_rnn; const float* w_out_attn; const float* w_o;
    const float* g_final; float* out; char* ws;
    float inv_freq[16];
};

DI float bf2f(bf16_t v) { return __uint_as_float(((unsigned)v) << 16); }
DI bf16_t f2bf(float f) { unsigned u = __float_as_uint(f); u += 0x7fffu + ((u >> 16) & 1u); return (bf16_t)(u >> 16); }
DI float sigmoidf_(float v) { return 1.0f / (1.0f + __expf(-v)); }
DI float siluf_(float v) { return v / (1.0f + __expf(-v)); }
DI float wave_sum(float v) {
#pragma unroll
    for (int o = 32; o >= 1; o >>= 1) v += __shfl_xor(v, o);
    return v;
}

__global__ __launch_bounds__(512) void k_mod(Params p) {
    __shared__ float cact[8 * 1024];
    __shared__ float red[8 * 64 * 8];
    const int tid = threadIdx.x;
    for (int i = tid; i < 8 * 1024; i += 512) cact[i] = siluf_(p.c[i]);
    __syncthreads();
    const int col = blockIdx.x * 64 + (tid & 63), ks = tid >> 6;
    float acc[8];
#pragma unroll
    for (int b = 0; b < 8; ++b) acc[b] = 0.f;
    for (int k = ks * 128; k < ks * 128 + 128; ++k) {
        const float w = p.w_mod[(size_t)k * 3072 + col];
#pragma unroll
        for (int b = 0; b < 8; ++b) acc[b] += cact[b * 1024 + k] * w;
    }
#pragma unroll
    for (int b = 0; b < 8; ++b) red[(ks * 64 + (tid & 63)) * 8 + b] = acc[b];
    __syncthreads();
    {
        const int cc = tid & 63, b = tid >> 6;
        float s = 0.f;
        for (int k2 = 0; k2 < 8; ++k2) s += red[(k2 * 64 + cc) * 8 + b];
        float* mod = (float*)(p.ws + OFF_MOD);
        mod[b * 3072 + blockIdx.x * 64 + cc] = s + p.b_mod[blockIdx.x * 64 + cc];
    }
}

__global__ __launch_bounds__(512) void k_h(Params p) {
    const int lane = threadIdx.x & 63, wid = threadIdx.x >> 6;
    const int row = blockIdx.x * 8 + wid;
    const int b = row / SEQ;
    const float* mod = (const float*)(p.ws + OFF_MOD);
    const float* xr = p.x + (size_t)row * D;
    float4 v[4]; float ss = 0.f;
#pragma unroll
    for (int i = 0; i < 4; ++i) { v[i] = *(const float4*)(xr + i * 256 + lane * 4); ss += v[i].x * v[i].x + v[i].y * v[i].y + v[i].z * v[i].z + v[i].w * v[i].w; }
    ss = wave_sum(ss);
    const float rstd = rsqrtf(ss * (1.0f / D) + 1e-6f);
    bf16_t* hb = (bf16_t*)(p.ws + OFF_H) + (size_t)row * D;
#pragma unroll
    for (int i = 0; i < 4; ++i) {
        const int c0 = i * 256 + lane * 4;
        const float4 g = *(const float4*)(p.g_norm + c0);
        const float4 sh = *(const float4*)(mod + b * 3072 + c0);
        const float4 sc = *(const float4*)(mod + b * 3072 + 1024 + c0);
        ushort4 o;
        o.x = f2bf(v[i].x * rstd * g.x * (1.f + sc.x) + sh.x);
        o.y = f2bf(v[i].y * rstd * g.y * (1.f + sc.y) + sh.y);
        o.z = f2bf(v[i].z * rstd * g.z * (1.f + sc.z) + sh.z);
        o.w = f2bf(v[i].w * rstd * g.w * (1.f + sc.w) + sh.w);
        *(ushort4*)(hb + c0) = o;
    }
    if (lane < 16) {
        const float ang = (float)p.pos[row] * p.inv_freq[lane];
        float s, c; sincosf(ang, &s, &c);
        float2* tab = (float2*)(p.ws + OFF_ROPE);
        tab[(size_t)row * 16 + lane] = make_float2(c, s);
    }
}

DI void naive_tile(float (&acc)[4][4], const bf16_t* A, int lda, const float* W, int ldw, int K, int row0, float* As, float* Bs) {
    const int tid = threadIdx.x, tx = tid & 15, ty = tid >> 4;
    for (int k0 = 0; k0 < K; k0 += 16) {
        {
            const int r = tid >> 2, k4 = (tid & 3) * 4;
            const ushort4 a = *(const ushort4*)(A + (size_t)(row0 + r) * lda + k0 + k4);
            As[(k4 + 0) * 68 + r] = bf2f(a.x); As[(k4 + 1) * 68 + r] = bf2f(a.y); As[(k4 + 2) * 68 + r] = bf2f(a.z); As[(k4 + 3) * 68 + r] = bf2f(a.w);
            const int kk = tid >> 4, n4 = (tid & 15) * 4;
            *(float4*)(Bs + kk * 64 + n4) = *(const float4*)(W + (size_t)(k0 + kk) * ldw + n4);
        }
        __syncthreads();
#pragma unroll
        for (int kk = 0; kk < 16; ++kk) {
            const float4 a = *(const float4*)(As + kk * 68 + ty * 4);
            const float4 b = *(const float4*)(Bs + kk * 64 + tx * 4);
            const float av[4] = {a.x, a.y, a.z, a.w}, bv[4] = {b.x, b.y, b.z, b.w};
#pragma unroll
            for (int i = 0; i < 4; ++i)
#pragma unroll
                for (int j = 0; j < 4; ++j) acc[i][j] += av[i] * bv[j];
        }
        __syncthreads();
    }
}

template <int MODE> __global__ __launch_bounds__(256) void k_gemm_naive(Params p) {
    __shared__ float As[16 * 68];
    __shared__ float Bs[16 * 64];
    const int tid = threadIdx.x, tx = tid & 15, ty = tid >> 4;
    const int n0 = blockIdx.x * 64, row0 = blockIdx.y * 64;
    bf16_t* P6 = (bf16_t*)(p.ws + OFF_P6);
    const float* mod = (const float*)(p.ws + OFF_MOD);
    float acc[4][4] = {};
    if (MODE == 0) {
        const int sec = n0 / 1024;
        const int wbase = (sec == 0 ? 0 : sec == 1 ? 2048 : sec == 2 ? 3072 : sec == 3 ? 4096 : sec == 4 ? 1024 : 5120) + (n0 & 1023);
        naive_tile(acc, (const bf16_t*)(p.ws + OFF_H), D, p.w_in + wbase, 8192, 1024, row0, As, Bs);
#pragma unroll
        for (int i = 0; i < 4; ++i) {
            ushort4 o; o.x = f2bf(acc[i][0]); o.y = f2bf(acc[i][1]); o.z = f2bf(acc[i][2]); o.w = f2bf(acc[i][3]);
            *(ushort4*)(P6 + (size_t)(row0 + ty * 4 + i) * NP + n0 + tx * 4) = o;
        }
    } else if (MODE == 1) {
        naive_tile(acc, (const bf16_t*)(p.ws + OFF_H), D, p.w_in + 6144 + n0, 8192, 1024, row0, As, Bs);
#pragma unroll
        for (int i = 0; i < 4; ++i) {
            ushort4 o; const int n = n0 + tx * 4;
            o.x = f2bf(sigmoidf_(acc[i][0] + p.b_gate[n])); o.y = f2bf(sigmoidf_(acc[i][1] + p.b_gate[n + 1]));
            o.z = f2bf(sigmoidf_(acc[i][2] + p.b_gate[n + 2])); o.w = f2bf(sigmoidf_(acc[i][3] + p.b_gate[n + 3]));
            *(ushort4*)(P6 + (size_t)(row0 + ty * 4 + i) * NP + C_K + n) = o;
        }
    } else if (MODE == 2) {
        float acc2[4][4] = {};
        naive_tile(acc, P6 + C_ZR, NP, p.w_out_rnn + n0, 1024, 1024, row0, As, Bs);
        naive_tile(acc2, P6 + C_ZA, NP, p.w_out_attn + n0, 1024, 1024, row0, As, Bs);
#pragma unroll
        for (int i = 0; i < 4; ++i) {
            const size_t rb = (size_t)(row0 + ty * 4 + i) * NP; const int n = n0 + tx * 4;
            const ushort4 gr = *(const ushort4*)(P6 + rb + C_K + n), ga = *(const ushort4*)(P6 + rb + C_K + 1024 + n);
            ushort4 o;
            o.x = f2bf(bf2f(gr.x) * acc[i][0] + bf2f(ga.x) * acc2[i][0]); o.y = f2bf(bf2f(gr.y) * acc[i][1] + bf2f(ga.y) * acc2[i][1]);
            o.z = f2bf(bf2f(gr.z) * acc[i][2] + bf2f(ga.z) * acc2[i][2]); o.w = f2bf(bf2f(gr.w) * acc[i][3] + bf2f(ga.w) * acc2[i][3]);
            *(ushort4*)(P6 + rb + C_Q + n) = o;
        }
    } else {
        naive_tile(acc, P6 + C_Q, NP, p.w_o + n0, 1024, 1024, row0, As, Bs);
#pragma unroll
        for (int i = 0; i < 4; ++i) {
            const int row = row0 + ty * 4 + i, n = n0 + tx * 4, b = row / SEQ;
            const float4 xv = *(const float4*)(p.x + (size_t)row * D + n);
            const float4 g = *(const float4*)(mod + b * 3072 + 2048 + n);
            float4 o; o.x = xv.x + g.x * acc[i][0]; o.y = xv.y + g.y * acc[i][1]; o.z = xv.z + g.z * acc[i][2]; o.w = xv.w + g.w * acc[i][3];
            *(float4*)(p.out + (size_t)row * D + n) = o;
        }
    }
}

__global__ __launch_bounds__(256) void k_rope_naive(Params p) {
    const size_t gid = (size_t)blockIdx.x * 256 + threadIdx.x;
    const int i = gid & 15, h = (gid >> 4) & 7, sec = (gid >> 7) & 1; const size_t tok = gid >> 8;
    bf16_t* P6 = (bf16_t*)(p.ws + OFF_P6);
    bf16_t* base = P6 + tok * NP + (sec ? C_K : C_Q) + h * 128;
    const float2 cs = ((const float2*)(p.ws + OFF_ROPE))[tok * 16 + i];
    const float x1 = bf2f(base[i]), x2 = bf2f(base[16 + i]);
    const float sc = sec ? 1.0f : QSCALE;
    base[i] = f2bf((x1 * cs.x - x2 * cs.y) * sc);
    base[16 + i] = f2bf((x2 * cs.x + x1 * cs.y) * sc);
    if (!sec) for (int d = 32 + i * 6; d < 32 + i * 6 + 6; ++d) base[d] = f2bf(bf2f(base[d]) * sc);
}

__global__ __launch_bounds__(512) void k_attn_naive(Params p) {
    const int lane = threadIdx.x & 63, wid = threadIdx.x >> 6;
    const size_t gw = (size_t)blockIdx.x * 8 + wid;
    const int h = gw & 7; const size_t tok = gw >> 3; const int t = tok % SEQ; const size_t tb = tok - t;
    bf16_t* P6 = (bf16_t*)(p.ws + OFF_P6);
    const unsigned qv = *(const unsigned*)(P6 + tok * NP + C_Q + h * 128 + lane * 2);
    const float q0 = bf2f(qv & 0xffff), q1 = bf2f(qv >> 16);
    float m = -1e30f, l = 0.f, o0 = 0.f, o1 = 0.f;
    for (int g = 0; g < 3; ++g) {
        const int dil = g == 0 ? 1 : g == 1 ? 4 : 16;
        for (int j = 0; j <= 128; ++j) {
            const int kp = t - j * dil; if (kp < 0) break;
            const bf16_t* kr = P6 + (tb + kp) * NP + h * 128 + lane * 2;
            const unsigned kv = *(const unsigned*)(kr + C_K), vv = *(const unsigned*)(kr + C_V);
            float s = q0 * bf2f(kv & 0xffff) + q1 * bf2f(kv >> 16);
            s = wave_sum(s);
            const float mn = fmaxf(m, s), al = exp2f(m - mn), pp = exp2f(s - mn);
            l = l * al + pp; o0 = o0 * al + pp * bf2f(vv & 0xffff); o1 = o1 * al + pp * bf2f(vv >> 16); m = mn;
        }
    }
    bf16_t* zp = P6 + tok * NP + C_ZA + h * 128 + lane * 2;
    const unsigned zv = *(const unsigned*)zp;
    const float r0 = o0 / l * siluf_(bf2f(zv & 0xffff)), r1 = o1 / l * siluf_(bf2f(zv >> 16));
    *(unsigned*)zp = (unsigned)f2bf(r0) | ((unsigned)f2bf(r1) << 16);
}

__global__ __launch_bounds__(256) void k_rnn_naive(Params p) {
    extern __shared__ __attribute__((aligned(16))) float sm[];
    float* wsm = sm;
    float* xcs = sm + 2 * 128 * 128;
    float* ig = xcs + 128;
    const int tid = threadIdx.x, j = tid & 127, gate = tid >> 7;
    const int b = blockIdx.x >> 3, hb = blockIdx.x & 7, ch = hb * 128 + j;
    for (int i = tid; i < 128 * 128; i += 256) { wsm[i] = p.w_a[hb * 16384 + i]; wsm[16384 + i] = p.w_x[hb * 16384 + i]; }
    bf16_t* P6 = (bf16_t*)(p.ws + OFF_P6);
    const float cw0 = p.conv_w[ch], cw1 = p.conv_w[1024 + ch], cw2 = p.conv_w[2048 + ch], cw3 = p.conv_w[3072 + ch], cb = p.conv_b[ch];
    const float bias = gate ? p.b_x[ch] : p.b_a[ch];
    const float sp8 = -8.0f * log1pf(__expf(-p.lam[ch]));
    float x0 = 0.f, x1 = 0.f, x2 = 0.f, hst = 0.f;
    __syncthreads();
    const float* wcol = wsm + gate * 16384 + j;
    for (int t = 0; t < SEQ; ++t) {
        const size_t tok = (size_t)b * SEQ + t;
        float xc = 0.f;
        if (gate == 0) {
            const float x3 = bf2f(P6[tok * NP + C_XR + ch]);
            xc = cw0 * x0 + cw1 * x1 + cw2 * x2 + cw3 * x3 + cb;
            x0 = x1; x1 = x2; x2 = x3;
            xcs[j] = xc;
        }
        __syncthreads();
        float d = bias;
#pragma unroll 8
        for (int i = 0; i < 128; ++i) d += xcs[i] * wcol[i * 128];
        const float sg = sigmoidf_(d);
        if (gate == 1) ig[j] = sg;
        __syncthreads();
        if (gate == 0) {
            const float la = sp8 * sg;
            const bool rst = p.pos[tok] == 0;
            const float a = rst ? 0.f : __expf(la);
            const float mult = rst ? 1.f : sqrtf(-expm1f(2.f * la));
            hst = a * hst + mult * ig[j] * xc;
            bf16_t* zp = P6 + tok * NP + C_ZR + ch;
            *zp = f2bf(hst * siluf_(bf2f(*zp)));
        }
    }
}

__global__ __launch_bounds__(512) void k_final(Params p) {
    const int lane = threadIdx.x & 63, wid = threadIdx.x >> 6;
    const int row = blockIdx.x * 8 + wid;
    float* xr = p.out + (size_t)row * D;
    float4 v[4]; float ss = 0.f;
#pragma unroll
    for (int i = 0; i < 4; ++i) { v[i] = *(const float4*)(xr + i * 256 + lane * 4); ss += v[i].x * v[i].x + v[i].y * v[i].y + v[i].z * v[i].z + v[i].w * v[i].w; }
    ss = wave_sum(ss);
    const float rstd = rsqrtf(ss * (1.0f / D) + 1e-6f);
#pragma unroll
    for (int i = 0; i < 4; ++i) {
        const float4 g = *(const float4*)(p.g_final + i * 256 + lane * 4);
        float4 o; o.x = v[i].x * rstd * g.x; o.y = v[i].y * rstd * g.y; o.z = v[i].z * rstd * g.z; o.w = v[i].w * rstd * g.w;
        *(float4*)(xr + i * 256 + lane * 4) = o;
    }
}

extern "C" void kernel_launch(void* const* d_in, const int* in_sizes, int n_in, void* d_out, int out_size, void* d_ws, size_t ws_size,
                              hipStream_t stream) {
    Params p{};
    p.x = (const float*)d_in[0]; p.c = (const float*)d_in[1]; p.pos = (const int*)d_in[2]; p.g_norm = (const float*)d_in[3];
    p.w_mod = (const float*)d_in[4]; p.b_mod = (const float*)d_in[5]; p.w_in = (const float*)d_in[6]; p.b_gate = (const float*)d_in[7];
    p.conv_w = (const float*)d_in[8]; p.conv_b = (const float*)d_in[9]; p.w_a = (const float*)d_in[10]; p.b_a = (const float*)d_in[11];
    p.w_x = (const float*)d_in[12]; p.b_x = (const float*)d_in[13]; p.lam = (const float*)d_in[14]; p.w_out_rnn = (const float*)d_in[15];
    p.w_out_attn = (const float*)d_in[16]; p.w_o = (const float*)d_in[17]; p.g_final = (const float*)d_in[18];
    p.out = (float*)d_out; p.ws = (char*)d_ws;
    for (int i = 0; i < 16; ++i) p.inv_freq[i] = (float)pow(500000.0, -(double)(2 * i) / 32.0);
    if (ws_size < OFF_END) { fprintf(stderr, "workspace too small: %zu < %zu\n", ws_size, (size_t)OFF_END); return; }
    static bool attr = false;
    if (!attr) { hipFuncSetAttribute((const void*)k_rnn_naive, hipFuncAttributeMaxDynamicSharedMemorySize, 2 * 128 * 128 * 4 + 1024); attr = true; }
    k_mod<<<48, 512, 0, stream>>>(p);
    k_h<<<M / 8, 512, 0, stream>>>(p);
    k_gemm_naive<0><<<dim3(NP / 64, M / 64), 256, 0, stream>>>(p);
    k_rope_naive<<<(unsigned)((size_t)M * 256 / 256), 256, 0, stream>>>(p);
    k_rnn_naive<<<64, 256, 2 * 128 * 128 * 4 + 1024, stream>>>(p);
    k_attn_naive<<<M, 512, 0, stream>>>(p);
    k_gemm_naive<1><<<dim3(2048 / 64, M / 64), 256, 0, stream>>>(p);
    k_gemm_naive<2><<<dim3(1024 / 64, M / 64), 256, 0, stream>>>(p);
    k_gemm_naive<3><<<dim3(1024 / 64, M / 64), 256, 0, stream>>>(p);
    k_final<<<M / 8, 512, 0, stream>>>(p);
}
```

```cpp
#include <hip/hip_runtime.h>
#include <hip/hip_bf16.h>
#include <hip/hip_cooperative_groups.h>
#include <cstdio>
#include <cstdint>
#include <cmath>
namespace cg = cooperative_groups;

typedef unsigned short bf16_t;
#define DI __device__ __forceinline__
#define LAS __attribute__((address_space(3)))
typedef short bf16x8 __attribute__((ext_vector_type(8)));
typedef float f32x4 __attribute__((ext_vector_type(4)));
typedef unsigned u32x2 __attribute__((ext_vector_type(2)));
typedef unsigned u32x4 __attribute__((ext_vector_type(4)));

constexpr int D = 1024, BATCH = 8, SEQ = 8192, M = BATCH * SEQ;
constexpr int NP = 6144;
constexpr int NPX = 3072;
constexpr int CX_XR = 0, CX_ZR = 1024, CX_ZA = 2048;
constexpr float QSCALE = 0.08838834764831845f * 1.4426950408889634f;
constexpr int LDS_BYTES = 163840;

constexpr size_t OFF_PX = 0;
constexpr size_t OFF_QH = OFF_PX + (size_t)M * NPX * 2;
constexpr size_t OFF_KH = OFF_QH + (size_t)M * 1024 * 2;
constexpr size_t OFF_VH = OFF_KH + (size_t)M * 1024 * 2;
constexpr size_t OFF_H = OFF_VH + (size_t)M * 1024 * 2;
constexpr size_t OFF_WINT = OFF_H + (size_t)M * D * 2;
constexpr size_t OFF_WGL = OFF_WINT + (size_t)6144 * 1024 * 2;
constexpr size_t OFF_WR = OFF_WGL + (size_t)2048 * 1024 * 2;
constexpr size_t OFF_WA = OFF_WR + (size_t)1024 * 1024 * 2;
constexpr size_t OFF_WO = OFF_WA + (size_t)1024 * 1024 * 2;
constexpr size_t OFF_WGT = OFF_WO + (size_t)1024 * 1024 * 2;
constexpr size_t OFF_MOD = OFF_WGT + (size_t)8 * 256 * 128 * 2;
constexpr size_t OFF_SP = OFF_MOD + 131072;
constexpr size_t OFF_ROPE = OFF_SP + 4096;
constexpr size_t OFF_SUM = OFF_ROPE + (size_t)M * 16 * 8;
constexpr size_t OFF_LSE = OFF_SUM + (size_t)2 * 8 * 64 * 1024 * 4;
constexpr size_t OFF_ROWSQ = OFF_LSE + (size_t)2 * M * 8 * 4;
constexpr size_t OFF_BAR = OFF_ROWSQ + (size_t)M * 16 * 4;
constexpr size_t BAR_BYTES = 16384 + 65536;
constexpr size_t OFF_END = OFF_BAR + BAR_BYTES;

struct Params {
    const float* x; const float* c; const int* pos; const float* g_norm; const float* w_mod; const float* b_mod;
    const float* w_in; const float* b_gate; const float* conv_w; const float* conv_b; const float* w_a; const float* b_a;
    const float* w_x; const float* b_x; const float* lam; const float* w_out_rnn; const float* w_out_attn; const float* w_o;
    const float* g_final; float* out; char* ws;
    float inv_freq[16];
    int ph_lo, ph_hi;
};

DI float bf2f(bf16_t v) { return __uint_as_float(((unsigned)v) << 16); }
DI bf16_t f2bf(float f) { unsigned u = __float_as_uint(f); u += 0x7fffu + ((u >> 16) & 1u); return (bf16_t)(u >> 16); }
typedef __bf16 bf16x2_t __attribute__((ext_vector_type(2)));
typedef float f32x2_t __attribute__((ext_vector_type(2)));
DI unsigned pk2(float lo, float hi) { const f32x2_t v = {lo, hi}; return __builtin_bit_cast(unsigned, __builtin_convertvector(v, bf16x2_t)); }
DI float bflo(unsigned w) { return __uint_as_float(w << 16); }
DI float bfhi(unsigned w) { return __uint_as_float(w & 0xffff0000u); }
DI float sigmoidf_(float v) { return 1.0f / (1.0f + __expf(-v)); }
DI float siluf_(float v) { return v / (1.0f + __expf(-v)); }
DI float fsig(float v) { return __builtin_amdgcn_rcpf(1.0f + __builtin_amdgcn_exp2f(-1.4426950408889634f * v)); }
DI float wave_sum(float v) {
#pragma unroll
    for (int o = 32; o >= 1; o >>= 1) v += __shfl_xor(v, o);
    return v;
}

namespace pg8 {
constexpr int BM = 256, BK = 64, HALF = 128, HTB = HALF * BK * 2, STAGE_BYTES = 8 * HTB, NXCD = 8, WGM = 8;
DI int lds_byte(int r, int c) { const int st = (r >> 4) * 2 + (c >> 5), rr = r & 15, cc = c & 31, ob = rr * 64 + cc * 2; return st * 1024 + (ob ^ (((ob >> 9) & 1) << 5)); }
DI void stage_rc(int b, int& R, int& C) { const int st = b / 1024, sb = b % 1024, swz = sb ^ (((sb >> 9) & 1) << 5); R = (st >> 1) * 16 + swz / 64; C = (st & 1) * 32 + (swz % 64) / 2; }

DI int perm32(int rho) { const int n = rho >> 4, i = rho & 15; return 8 * (i >> 2) + 4 * n + (i & 3); }
struct Unit { int pm, pn, sub; const char* a; const char* b; };

struct TileSched {
    int nM, nN, nwg, G, c, nsub; const char* A0; const char* A1; const char* B0; const char* B1; size_t tstepA, tstepB;
    DI void init(int M_, int N_, int G_, int c_, int nsub_, const void* a0, const void* a1, int lda, const void* b0, const void* b1, int ldb) {
        nM = M_ / BM; nN = N_ / BM; nwg = nM * nN; G = G_; c = c_; nsub = nsub_;
        A0 = (const char*)a0; A1 = (const char*)a1; B0 = (const char*)b0; B1 = (const char*)b1;
        tstepA = (size_t)BM * lda * 2; tstepB = (size_t)BM * ldb * 2;
    }
    DI bool next(int i, Unit& u) const {
        const int ti = (nsub == 2) ? (i >> 1) : i, sub = (nsub == 2) ? (i & 1) : 0;
        const long L = (long)ti * G + c; if (L >= nwg) return false;
        int wgid = (int)L; { const int q = nwg / NXCD, r = nwg % NXCD, xcd = wgid % NXCD, off = wgid / NXCD; wgid = (xcd < r ? xcd * (q + 1) : r * (q + 1) + (xcd - r) * q) + off; }
        const int nig = WGM * nN, gid = wgid / nig, fm = gid * WGM, gsz = (nM - fm) < WGM ? (nM - fm) : WGM;
        u.pm = fm + ((wgid % nig) % gsz); u.pn = (wgid % nig) / gsz; u.sub = sub;
        u.a = (sub ? A1 : A0) + (size_t)u.pm * tstepA; u.b = (sub ? B1 : B0) + (size_t)u.pn * tstepB; return true;
    }
};

template <class Epi, class Sched, bool ALIGN_EPI, bool SP2>
DI void gemm_phase(LAS unsigned char* lds, const int lda, const int ldb, const int nt, const Sched& S, const Epi& E) {
    const int tid = threadIdx.x, wid = __builtin_amdgcn_readfirstlane(tid >> 6), lane = tid & 63, wr = wid >> 2, wc = wid & 3, fr = lane & 15, fq = lane >> 4;
    unsigned voffA[2], voffB[2];
#pragma unroll
    for (int i = 0; i < 2; ++i) { int R, C; stage_rc(tid * 16 + i * 8192, R, C); const int Rb = (R & ~31) + perm32(R & 31); voffA[i] = (unsigned)(R * lda + C) * 2u; voffB[i] = (unsigned)(Rb * ldb + C) * 2u; }
    const size_t kstep = (size_t)(BK * 2);
    const size_t hstepA = (size_t)HALF * lda * 2, hstepB = (size_t)HALF * ldb * 2;
    const unsigned ldsw = (unsigned)wid * 1024u;
    const int aoff = lds_byte(wr * 64 + fr, fq * 8), boff = lds_byte(wc * 32 + fr, fq * 8);
#define PG8_SA(b, h) (((b) * 2 + (h)) * HTB)
#define PG8_SB(b, h) ((4 + (b) * 2 + (h)) * HTB)
#define PG8_STAGE(bufoff, gbase, voff) do { _Pragma("unroll") for (int _i = 0; _i < 2; ++_i) \
        __builtin_amdgcn_global_load_lds((const unsigned*)((const char*)(gbase) + (voff)[_i]), (LAS unsigned*)(lds + (bufoff) + ldsw + _i * 8192), 16, 0, 0); } while (0)
#define PG8_LDA(dst, b, h) do { _Pragma("unroll") for (int m = 0; m < 4; ++m) _Pragma("unroll") for (int k = 0; k < 2; ++k) dst[m][k] = *(const LAS bf16x8*)(lds + PG8_SA(b, h) + aoff + m * 2048 + k * 1024); } while (0)
#define PG8_LDB(dst, b, h) do { _Pragma("unroll") for (int n = 0; n < 2; ++n) _Pragma("unroll") for (int k = 0; k < 2; ++k) dst[n][k] = *(const LAS bf16x8*)(lds + PG8_SB(b, h) + boff + n * 2048 + k * 1024); } while (0)
#define PG8_MMA(ai, bj, At, Bt) do { __builtin_amdgcn_s_setprio(1); _Pragma("unroll") for (int m = 0; m < 4; ++m) _Pragma("unroll") for (int n = 0; n < 2; ++n) _Pragma("unroll") for (int k = 0; k < 2; ++k) \
        acc[ai][bj][m][n] = __builtin_amdgcn_mfma_f32_16x16x32_bf16(Bt[n][k], At[m][k], acc[ai][bj][m][n], 0, 0, 0); __builtin_amdgcn_s_setprio(0); } while (0)
#define PG8_WAIT_V(n) asm volatile("s_waitcnt vmcnt(" #n ")" ::: "memory")
#define PG8_WAIT_L(n) asm volatile("s_waitcnt lgkmcnt(" #n ")" ::: "memory")
#define PG8_BAR __builtin_amdgcn_s_barrier()
#define PG8_SCHED __builtin_amdgcn_sched_barrier(0)
    Unit cur, nxt; int ui = 0;
    if (!S.next(0, cur)) return;
    f32x4 acc[2][2][4][2];
#pragma unroll
    for (int a = 0; a < 2; ++a)
#pragma unroll
        for (int b = 0; b < 2; ++b)
#pragma unroll
            for (int m = 0; m < 4; ++m)
#pragma unroll
                for (int n = 0; n < 2; ++n) acc[a][b][m][n] = (f32x4){0.f, 0.f, 0.f, 0.f};
    bf16x8 At[4][2], B0[2][2], B1[2][2];
    const char* cA = cur.a; const char* cB = cur.b;
    if constexpr (SP2) {
        PG8_STAGE(PG8_SB(0, 0), cB, voffB); PG8_STAGE(PG8_SB(0, 1), cB + hstepB, voffB); PG8_STAGE(PG8_SA(0, 0), cA, voffA); PG8_STAGE(PG8_SA(0, 1), cA + hstepA, voffA);
        if (wr == 1) PG8_BAR;
        PG8_WAIT_V(2); PG8_BAR;
        PG8_STAGE(PG8_SB(1, 0), cB + kstep, voffB); PG8_STAGE(PG8_SA(1, 0), cA + kstep, voffA); PG8_STAGE(PG8_SB(1, 1), cB + hstepB + kstep, voffB);
        PG8_WAIT_V(6); PG8_BAR;
    } else {
        PG8_STAGE(PG8_SB(0, 0), cB, voffB); PG8_STAGE(PG8_SA(0, 0), cA, voffA); PG8_STAGE(PG8_SB(0, 1), cB + hstepB, voffB); PG8_STAGE(PG8_SA(0, 1), cA + hstepA, voffA);
        if (wr == 1) PG8_BAR;
        PG8_WAIT_V(4); PG8_BAR;
        PG8_STAGE(PG8_SB(1, 0), cB + kstep, voffB); PG8_STAGE(PG8_SA(1, 0), cA + kstep, voffA); PG8_STAGE(PG8_SB(1, 1), cB + hstepB + kstep, voffB);
        PG8_WAIT_V(6); PG8_BAR;
    }
    for (;;) {
        const bool has_next = S.next(ui + 1, nxt);
        const char* nA = has_next ? nxt.a : cA; const char* nB = has_next ? nxt.b : cB;
        for (int t = 0; t < nt; t += 2) {
            const bool last = (t == nt - 2);
            const char* a1 = cA + (size_t)(t + 1) * kstep;
            const char* a2 = last ? nA : cA + (size_t)(t + 2) * kstep; const char* b2 = last ? nB : cB + (size_t)(t + 2) * kstep;
            const char* a3 = a2 + kstep; const char* b3 = b2 + kstep;
            if constexpr (SP2) {
            PG8_LDB(B0, 0, 0); PG8_LDB(B1, 0, 1); PG8_SCHED; PG8_LDA(At, 0, 0); PG8_STAGE(PG8_SA(1, 1), a1 + hstepA, voffA);
            PG8_WAIT_V(8); PG8_WAIT_L(0); PG8_BAR; PG8_MMA(0, 0, At, B0); PG8_MMA(0, 1, At, B1); PG8_BAR; PG8_SCHED;
            PG8_LDA(At, 0, 1); PG8_STAGE(PG8_SB(0, 0), b2, voffB); PG8_STAGE(PG8_SB(0, 1), b2 + hstepB, voffB); PG8_STAGE(PG8_SA(0, 0), a2, voffA);
            PG8_WAIT_V(8); PG8_WAIT_L(0); PG8_BAR; PG8_MMA(1, 0, At, B0); PG8_MMA(1, 1, At, B1); PG8_BAR; PG8_SCHED;
            PG8_LDB(B0, 1, 0); PG8_LDB(B1, 1, 1); PG8_SCHED; PG8_LDA(At, 1, 0); PG8_STAGE(PG8_SA(0, 1), a2 + hstepA, voffA);
            PG8_WAIT_V(8); PG8_WAIT_L(0); PG8_BAR; PG8_MMA(0, 0, At, B0); PG8_MMA(0, 1, At, B1); PG8_BAR; PG8_SCHED;
            PG8_LDA(At, 1, 1); PG8_STAGE(PG8_SB(1, 0), b3, voffB); PG8_STAGE(PG8_SB(1, 1), b3 + hstepB, voffB); PG8_STAGE(PG8_SA(1, 0), a3, voffA);
            PG8_WAIT_V(8); PG8_WAIT_L(0); PG8_BAR; PG8_MMA(1, 0, At, B0); PG8_MMA(1, 1, At, B1); PG8_BAR; PG8_SCHED;
            } else {
            PG8_LDB(B0, 0, 0); PG8_SCHED; PG8_LDA(At, 0, 0); PG8_STAGE(PG8_SA(1, 1), a1 + hstepA, voffA);
            PG8_WAIT_L(8); PG8_BAR; PG8_WAIT_L(0); PG8_MMA(0, 0, At, B0); PG8_BAR; PG8_SCHED;
            PG8_LDB(B1, 0, 1); PG8_STAGE(PG8_SB(0, 0), b2, voffB);
            PG8_BAR; PG8_WAIT_L(0); PG8_MMA(0, 1, At, B1); PG8_BAR;
            PG8_LDA(At, 0, 1); PG8_STAGE(PG8_SA(0, 0), a2, voffA);
            PG8_BAR; PG8_WAIT_L(0); PG8_MMA(1, 0, At, B0); PG8_BAR; PG8_SCHED;
            PG8_STAGE(PG8_SB(0, 1), b2 + hstepB, voffB);
            PG8_WAIT_V(6); PG8_BAR; PG8_MMA(1, 1, At, B1); PG8_BAR;
            PG8_LDB(B0, 1, 0); PG8_SCHED; PG8_LDA(At, 1, 0); PG8_STAGE(PG8_SA(0, 1), a2 + hstepA, voffA);
            PG8_WAIT_L(8); PG8_BAR; PG8_WAIT_L(0); PG8_MMA(0, 0, At, B0); PG8_BAR; PG8_SCHED;
            PG8_LDB(B1, 1, 1); PG8_STAGE(PG8_SB(1, 0), b3, voffB);
            PG8_BAR; PG8_WAIT_L(0); PG8_MMA(0, 1, At, B1); PG8_BAR;
            PG8_LDA(At, 1, 1); PG8_STAGE(PG8_SA(1, 0), a3, voffA);
            PG8_BAR; PG8_WAIT_L(0); PG8_MMA(1, 0, At, B0); PG8_BAR; PG8_SCHED;
            PG8_STAGE(PG8_SB(1, 1), b3 + hstepB, voffB);
            PG8_WAIT_V(6); PG8_BAR; PG8_MMA(1, 1, At, B1); PG8_BAR;
            }
        }
        if constexpr (ALIGN_EPI) { if (wr == 0) PG8_BAR; }
        const bool rst = E(acc, cur, wr, wc, fr, fq);
        if (!has_next) break;
        if (rst) {
#pragma unroll
            for (int a = 0; a < 2; ++a)
#pragma unroll
                for (int b = 0; b < 2; ++b)
#pragma unroll
                    for (int m = 0; m < 4; ++m)
#pragma unroll
                        for (int n = 0; n < 2; ++n) acc[a][b][m][n] = (f32x4){0.f, 0.f, 0.f, 0.f};
        }
        cur = nxt; cA = nA; cB = nB; ++ui;
        if constexpr (ALIGN_EPI) { if (wr == 1) PG8_BAR; }
    }
    PG8_WAIT_V(0);
    if constexpr (!ALIGN_EPI) { if (wr == 0) PG8_BAR; }
    PG8_BAR;
#undef PG8_SA
#undef PG8_SB
#undef PG8_STAGE
#undef PG8_LDA
#undef PG8_LDB
#undef PG8_MMA
#undef PG8_WAIT_V
#undef PG8_WAIT_L
#undef PG8_BAR
#undef PG8_SCHED
}
}

typedef f32x4 Acc[2][2][4][2];

struct EpiProj {
    bf16_t* PX; bf16_t* QH; const float* tab; LAS unsigned char* tl;
    DI bool operator()(Acc& acc, const pg8::Unit& u, int wr, int wc, int fr, int fq) const {
        const int sec = u.pn >> 2;
        const bool hm = (sec >= 1 && sec <= 3);
        const bool ropet = (sec == 1 || sec == 2);
        const size_t bjs = hm ? (size_t)SEQ * 128 : 128;
        if (ropet) {
            const int t = threadIdx.x, row = t >> 1, half = t & 1;
            const f32x4* src = (const f32x4*)(tab + (size_t)(u.pm * 256 + row) * 32 + half * 16);
            const f32x4 a = src[0], b = src[1], c = src[2], d = src[3];
            u32x4 w0, w1;
            w0.x = pk2(a[0], a[1]); w0.y = pk2(a[2], a[3]); w0.z = pk2(b[0], b[1]); w0.w = pk2(b[2], b[3]);
            w1.x = pk2(c[0], c[1]); w1.y = pk2(c[2], c[3]); w1.z = pk2(d[0], d[1]); w1.w = pk2(d[2], d[3]);
            *(LAS u32x4*)(tl + row * 64 + half * 32) = w0; *(LAS u32x4*)(tl + row * 64 + half * 32 + 16) = w1;
            __syncthreads();
        }
        const bool rope = ropet && wc == 0;
#pragma unroll
        for (int ai = 0; ai < 2; ++ai)
#pragma unroll
            for (int m = 0; m < 4; ++m) {
                const int rl = ai * 128 + wr * 64 + m * 16 + fr, row = u.pm * 256 + rl;
                bf16_t* rp;
                if (hm) rp = QH + (size_t)(sec - 1) * M * 1024 + ((size_t)((row >> 13) * 8 + (u.pn & 3) * 2) * SEQ + (row & (SEQ - 1))) * 128 + wc * 32 + fq * 8;
                else rp = PX + (size_t)row * NPX + (sec == 0 ? CX_XR : sec == 4 ? CX_ZR : CX_ZA) + (u.pn & 3) * 256 + wc * 32 + fq * 8;
                u32x4 cs0 = {0u, 0u, 0u, 0u}, cs1 = cs0;
                if (rope) { cs0 = *(const LAS u32x4*)(tl + rl * 64 + (fq & 1) * 32); cs1 = *(const LAS u32x4*)(tl + rl * 64 + (fq & 1) * 32 + 16); }
#pragma unroll
                for (int bj = 0; bj < 2; ++bj) {
                    f32x4 v0 = acc[ai][bj][m][0], v1 = acc[ai][bj][m][1];
                    if (rope) {
                        f32x4 p0, p1;
#pragma unroll
                        for (int j = 0; j < 4; ++j) { p0[j] = __shfl_xor(v0[j], 32); p1[j] = __shfl_xor(v1[j], 32); }
                        const float sg = (fq & 2) ? 1.0f : -1.0f;
#pragma unroll
                        for (int j = 0; j < 4; ++j) {
                            v0[j] = v0[j] * bflo(cs0[j]) + sg * p0[j] * bfhi(cs0[j]);
                            v1[j] = v1[j] * bflo(cs1[j]) + sg * p1[j] * bfhi(cs1[j]);
                        }
                    }
                    if (sec == 1) { v0 = v0 * QSCALE; v1 = v1 * QSCALE; }
                    u32x4 w; w.x = pk2(v0[0], v0[1]); w.y = pk2(v0[2], v0[3]); w.z = pk2(v1[0], v1[1]); w.w = pk2(v1[2], v1[3]);
                    __builtin_nontemporal_store(w, (u32x4*)(rp + bj * bjs));
                }
            }
        return true;
    }
};
struct EpiGate {
    bf16_t* KH; const float* bias;
    DI bool operator()(Acc& acc, const pg8::Unit& u, int wr, int wc, int fr, int fq) const {
        const int c0 = u.pn * 128 + wc * 32 + fq * 8;
#pragma unroll
        for (int ai = 0; ai < 2; ++ai)
#pragma unroll
            for (int m = 0; m < 4; ++m) {
                const int row = u.pm * 256 + ai * 128 + wr * 64 + m * 16 + fr;
                bf16_t* rp = KH + (size_t)row * 1024 + c0;
                float sr[8], sa[8];
#pragma unroll
                for (int n = 0; n < 2; ++n) {
                    const f32x4 vr = acc[ai][0][m][n] + *(const f32x4*)(bias + c0 + n * 4), va = acc[ai][1][m][n] + *(const f32x4*)(bias + 1024 + c0 + n * 4);
#pragma unroll
                    for (int j = 0; j < 4; ++j) {
                        const float er = 1.0f + __builtin_amdgcn_exp2f(-1.4426950408889634f * vr[j]), ea = 1.0f + __builtin_amdgcn_exp2f(-1.4426950408889634f * va[j]);
                        sa[n * 4 + j] = __builtin_amdgcn_rcpf(ea);
                        sr[n * 4 + j] = ea * __builtin_amdgcn_rcpf(er);
                    }
                }
                u32x4 w; w.x = pk2(sr[0], sr[1]); w.y = pk2(sr[2], sr[3]); w.z = pk2(sr[4], sr[5]); w.w = pk2(sr[6], sr[7]);
                *(u32x4*)rp = w;
                w.x = pk2(sa[0], sa[1]); w.y = pk2(sa[2], sa[3]); w.z = pk2(sa[4], sa[5]); w.w = pk2(sa[6], sa[7]);
                *(u32x4*)(rp + (size_t)M * 1024) = w;
            }
        return true;
    }
};
struct EpiMerged {
    bf16_t* QH;
    DI bool operator()(Acc& acc, const pg8::Unit& u, int wr, int wc, int fr, int fq) const {
        const int col0 = u.pn * 256 + wc * 32 + fq * 8;
        const size_t goff = (u.sub == 0) ? (size_t)M * 1024 : (size_t)2 * M * 1024;
#pragma unroll
        for (int ai = 0; ai < 2; ++ai) {
            u32x4 gg[4][2];
#pragma unroll
            for (int m = 0; m < 4; ++m) {
                const bf16_t* rp = QH + (size_t)(u.pm * 256 + ai * 128 + wr * 64 + m * 16 + fr) * 1024 + col0 + goff;
#pragma unroll
                for (int bj = 0; bj < 2; ++bj) gg[m][bj] = *(const u32x4*)(rp + bj * 128);
            }
#pragma unroll
            for (int m = 0; m < 4; ++m) {
                bf16_t* rp = QH + (size_t)(u.pm * 256 + ai * 128 + wr * 64 + m * 16 + fr) * 1024 + col0;
#pragma unroll
                for (int bj = 0; bj < 2; ++bj) {
                    const u32x4 a = gg[m][bj];
                    f32x4 v0 = acc[ai][bj][m][0], v1 = acc[ai][bj][m][1];
                    v0[0] *= bflo(a.x); v0[1] *= bfhi(a.x); v0[2] *= bflo(a.y); v0[3] *= bfhi(a.y);
                    v1[0] *= bflo(a.z); v1[1] *= bfhi(a.z); v1[2] *= bflo(a.w); v1[3] *= bfhi(a.w);
                    if (u.sub == 0) { acc[ai][bj][m][0] = v0; acc[ai][bj][m][1] = v1; }
                    else {
                        u32x4 w; w.x = pk2(v0[0], v0[1]); w.y = pk2(v0[2], v0[3]); w.z = pk2(v1[0], v1[1]); w.w = pk2(v1[2], v1[3]);
                        *(u32x4*)(rp + bj * 128) = w;
                    }
                }
            }
        }
        return u.sub != 0;
    }
};
struct EpiOut {
    const float* x; const float* mod; const float* gfin; float* out; float* rowsq; unsigned* cnt; LAS unsigned char* sl;
    DI bool operator()(Acc& acc, const pg8::Unit& u, int wr, int wc, int fr, int fq) const {
        const int col0 = u.pn * 256 + wc * 32 + fq * 8;
        const int wid = wr * 4 + wc, lane = fq * 16 + fr;
        LAS float* S = (LAS float*)sl;
        f32x4 gv[2][2];
        {
            const float* gp = mod + ((u.pm * 256) / SEQ) * 3072 + 2048 + col0;
#pragma unroll
            for (int bj = 0; bj < 2; ++bj)
#pragma unroll
                for (int n = 0; n < 2; ++n) gv[bj][n] = *(const f32x4*)(gp + bj * 128 + n * 4);
        }
#pragma unroll
        for (int ai = 0; ai < 2; ++ai) {
            f32x4 xv[4][2][2];
#pragma unroll
            for (int m = 0; m < 4; ++m) {
                const size_t ro = (size_t)(u.pm * 256 + ai * 128 + wr * 64 + m * 16 + fr) * D + col0;
#pragma unroll
                for (int bj = 0; bj < 2; ++bj)
#pragma unroll
                    for (int n = 0; n < 2; ++n) xv[m][bj][n] = *(const f32x4*)(x + ro + bj * 128 + n * 4);
            }
#pragma unroll
            for (int m = 0; m < 4; ++m) {
                const int row = u.pm * 256 + ai * 128 + wr * 64 + m * 16 + fr;
                float ss = 0.f;
#pragma unroll
                for (int bj = 0; bj < 2; ++bj)
#pragma unroll
                    for (int n = 0; n < 2; ++n) {
                        const f32x4 o = xv[m][bj][n] + gv[bj][n] * acc[ai][bj][m][n];
                        ss += o[0] * o[0] + o[1] * o[1] + o[2] * o[2] + o[3] * o[3];
                        acc[ai][bj][m][n] = o;
                    }
                ss += __shfl_xor(ss, 16); ss += __shfl_xor(ss, 32);
                if (fq == 0) __hip_atomic_store(rowsq + (size_t)row * 16 + u.pn * 4 + wc, ss, __ATOMIC_RELAXED, __HIP_MEMORY_SCOPE_AGENT);
            }
        }
        asm volatile("s_waitcnt vmcnt(0)" ::: "memory");
        unsigned* pc = cnt + 64 * u.pm;
        if (lane == 0) __hip_atomic_fetch_add(pc, 1u, __ATOMIC_RELAXED, __HIP_MEMORY_SCOPE_AGENT);
        if (wid == 0) {
            unsigned spins = 0;
            while ((unsigned)__builtin_amdgcn_readfirstlane(__hip_atomic_load(pc, __ATOMIC_RELAXED, __HIP_MEMORY_SCOPE_AGENT)) < 32u) {
                __builtin_amdgcn_s_sleep(2);
                if (++spins > (1u << 24)) break;
            }
            __builtin_amdgcn_fence(__ATOMIC_ACQUIRE, "agent");
            asm volatile("s_waitcnt vmcnt(0)" ::: "memory");
        }
        __syncthreads();
        if (threadIdx.x < 256) {
            const f32x4* sp = (const f32x4*)(rowsq + (size_t)(u.pm * 256 + threadIdx.x) * 16);
            const f32x4 a = sp[0], b2 = sp[1], c2 = sp[2], d2 = sp[3];
            const float t = (a[0] + a[1] + a[2] + a[3]) + (b2[0] + b2[1] + b2[2] + b2[3]) + (c2[0] + c2[1] + c2[2] + c2[3]) + (d2[0] + d2[1] + d2[2] + d2[3]);
            S[threadIdx.x] = rsqrtf(t * (1.0f / D) + 1e-6f);
        }
        __syncthreads();
        f32x4 gf[2][2];
#pragma unroll
        for (int bj = 0; bj < 2; ++bj)
#pragma unroll
            for (int n = 0; n < 2; ++n) gf[bj][n] = *(const f32x4*)(gfin + col0 + bj * 128 + n * 4);
#pragma unroll
        for (int ai = 0; ai < 2; ++ai)
#pragma unroll
            for (int m = 0; m < 4; ++m) {
                const int rl = ai * 128 + wr * 64 + m * 16 + fr;
                const float rs = S[rl];
                const size_t ro = (size_t)(u.pm * 256 + rl) * D + col0;
#pragma unroll
                for (int bj = 0; bj < 2; ++bj)
#pragma unroll
                    for (int n = 0; n < 2; ++n) *(f32x4*)(out + ro + bj * 128 + n * 4) = acc[ai][bj][m][n] * rs * gf[bj][n];
            }
        return true;
    }
};

DI void transpose_tile(const float* src, int lds_, int col0, int k0, bf16_t* dst, int ldd, int n0, float* tile) {
    const int tid = threadIdx.x;
    {
        const int k = tid >> 3, n8 = (tid & 7) * 8;
        const float4 a = *(const float4*)(src + (size_t)(k0 + k) * lds_ + col0 + n8);
        const float4 b = *(const float4*)(src + (size_t)(k0 + k) * lds_ + col0 + n8 + 4);
        float* t = tile + k * 65 + n8;
        t[0] = a.x; t[1] = a.y; t[2] = a.z; t[3] = a.w; t[4] = b.x; t[5] = b.y; t[6] = b.z; t[7] = b.w;
    }
    __syncthreads();
    {
        const int n = tid >> 3, k8 = (tid & 7) * 8;
        u32x4 w;
        w.x = pk2(tile[(k8 + 0) * 65 + n], tile[(k8 + 1) * 65 + n]); w.y = pk2(tile[(k8 + 2) * 65 + n], tile[(k8 + 3) * 65 + n]);
        w.z = pk2(tile[(k8 + 4) * 65 + n], tile[(k8 + 5) * 65 + n]); w.w = pk2(tile[(k8 + 6) * 65 + n], tile[(k8 + 7) * 65 + n]);
        *(u32x4*)(dst + (size_t)(n0 + n) * ldd + k0 + k8) = w;
    }
    __syncthreads();
}

DI void mod_task(const Params& p, int task, float* sm) {
    float* cact = sm;
    float* red = sm + 8 * 1024;
    const int tid = threadIdx.x;
    for (int i = tid; i < 8 * 1024; i += 512) cact[i] = siluf_(p.c[i]);
    __syncthreads();
    const int col = task * 64 + (tid & 63), ks = tid >> 6;
    float acc[8];
#pragma unroll
    for (int b = 0; b < 8; ++b) acc[b] = 0.f;
    for (int k = ks * 128; k < ks * 128 + 128; ++k) {
        const float w = p.w_mod[(size_t)k * 3072 + col];
#pragma unroll
        for (int b = 0; b < 8; ++b) acc[b] += cact[b * 1024 + k] * w;
    }
#pragma unroll
    for (int b = 0; b < 8; ++b) red[(ks * 64 + (tid & 63)) * 8 + b] = acc[b];
    __syncthreads();
    {
        const int cc = tid & 63, b = tid >> 6;
        float s = 0.f;
        for (int k2 = 0; k2 < 8; ++k2) s += red[(k2 * 64 + cc) * 8 + b];
        float* mod = (float*)(p.ws + OFF_MOD);
        mod[b * 3072 + task * 64 + cc] = s + p.b_mod[task * 64 + cc];
    }
    __syncthreads();
}

DI void phase_prologue(const Params& p, float* sm) {
    constexpr int T_WIN = 96 * 16, T_WGL = 32 * 16, T_SQ = 16 * 16, T_WGT = 64, T_MOD = 48;
    constexpr int E0 = T_WIN, E1 = E0 + T_WGL, E2 = E1 + T_SQ, E3 = E2 + T_SQ, E4 = E3 + T_SQ, E5 = E4 + T_WGT, E6 = E5 + T_MOD, E7 = E6 + 1;
    for (int t = blockIdx.x; t < E7; t += gridDim.x) {
        if (t < E0) {
            const int ntile = t >> 4, kt = t & 15, sec = ntile >> 4;
            const int wbase = (sec == 0 ? 0 : sec == 1 ? 2048 : sec == 2 ? 3072 : sec == 3 ? 4096 : sec == 4 ? 1024 : 5120) + (ntile & 15) * 64;
            transpose_tile(p.w_in, 8192, wbase, kt * 64, (bf16_t*)(p.ws + OFF_WINT), 1024, ntile * 64, sm);
        } else if (t < E1) {
            const int u = t - E0, ntile = u >> 4, kt = u & 15;
            transpose_tile(p.w_in, 8192, 6144 + ((ntile >> 1) & 1) * 1024 + (ntile >> 2) * 128 + (ntile & 1) * 64, kt * 64, (bf16_t*)(p.ws + OFF_WGL), 1024, ntile * 64, sm);
        } else if (t < E4) {
            const int which = t < E2 ? 0 : t < E3 ? 1 : 2;
            const int u = t - (which == 0 ? E1 : which == 1 ? E2 : E3), ntile = u >> 4, kt = u & 15;
            const float* src = which == 0 ? p.w_out_rnn : which == 1 ? p.w_out_attn : p.w_o;
            bf16_t* dst = (bf16_t*)(p.ws + (which == 0 ? OFF_WR : which == 1 ? OFF_WA : OFF_WO));
            transpose_tile(src, 1024, ntile * 64, kt * 64, dst, 1024, ntile * 64, sm);
        } else if (t < E5) {
            const int u = t - E4, hb = u >> 3, g = (u >> 2) & 1, nt2 = (u >> 1) & 1, kt = u & 1;
            const float* src = (g ? p.w_x : p.w_a) + hb * 16384;
            bf16_t* dst = (bf16_t*)(p.ws + OFF_WGT) + hb * 256 * 128;
            transpose_tile(src, 128, nt2 * 64, kt * 64, dst, 128, g * 128 + nt2 * 64, sm);
        } else if (t < E6) {
            mod_task(p, t - E5, sm);
        } else {
            float* sp = (float*)(p.ws + OFF_SP);
            for (int i = threadIdx.x; i < 1024; i += 512) sp[i] = -8.0f * log1pf(__expf(-p.lam[i]));
        }
    }
}

DI void phase_h(const Params& p) {
    const int lane = threadIdx.x & 63, wid = threadIdx.x >> 6;
    const float* mod = (const float*)(p.ws + OFF_MOD);
    float4 gn[4];
#pragma unroll
    for (int i = 0; i < 4; ++i) gn[i] = *(const float4*)(p.g_norm + i * 256 + lane * 4);
    for (int r16 = blockIdx.x; r16 < M / 16; r16 += gridDim.x) {
        const int row0 = r16 * 16 + wid * 2;
        const int b = row0 / SEQ;
        float4 v[2][4]; float ss[2] = {0.f, 0.f};
#pragma unroll
        for (int rr = 0; rr < 2; ++rr)
#pragma unroll
            for (int i = 0; i < 4; ++i) v[rr][i] = *(const float4*)(p.x + (size_t)(row0 + rr) * D + i * 256 + lane * 4);
#pragma unroll
        for (int rr = 0; rr < 2; ++rr) {
#pragma unroll
            for (int i = 0; i < 4; ++i) ss[rr] += v[rr][i].x * v[rr][i].x + v[rr][i].y * v[rr][i].y + v[rr][i].z * v[rr][i].z + v[rr][i].w * v[rr][i].w;
            ss[rr] = wave_sum(ss[rr]);
        }
#pragma unroll
        for (int i = 0; i < 4; ++i) {
            const int c0 = i * 256 + lane * 4;
            const float4 sh = *(const float4*)(mod + b * 3072 + c0);
            const float4 sc = *(const float4*)(mod + b * 3072 + 1024 + c0);
            const float4 g = gn[i];
#pragma unroll
            for (int rr = 0; rr < 2; ++rr) {
                const float rstd = rsqrtf(ss[rr] * (1.0f / D) + 1e-6f);
                u32x2 o;
                o.x = pk2(v[rr][i].x * rstd * g.x * (1.f + sc.x) + sh.x, v[rr][i].y * rstd * g.y * (1.f + sc.y) + sh.y);
                o.y = pk2(v[rr][i].z * rstd * g.z * (1.f + sc.z) + sh.z, v[rr][i].w * rstd * g.w * (1.f + sc.w) + sh.w);
                *(u32x2*)((bf16_t*)(p.ws + OFF_H) + (size_t)(row0 + rr) * D + c0) = o;
            }
        }
        if (lane < 32) {
            const int rr = lane >> 4, f = lane & 15;
            const float ang = (float)p.pos[row0 + rr] * p.inv_freq[f];
            float s, c; sincosf(ang, &s, &c);
            float2* tab = (float2*)(p.ws + OFF_ROPE);
            tab[(size_t)(row0 + rr) * 16 + f] = make_float2(c, s);
        }
    }
}

typedef float f32x16 __attribute__((ext_vector_type(16)));
DI int crow(int r, int hi) { return (r & 3) + 8 * (r >> 2) + 4 * hi; }
constexpr int RS = 272;
constexpr int R_WG = 0, R_XC = 256 * RS, R_Z = R_XC + 128 * RS, R_SUMS = R_Z + 32768, R_CAR = R_SUMS + 4096;

template <bool PASS2> DI void phase_rnn(const Params& p, unsigned char* lds) {
    LAS unsigned char* l3 = (LAS unsigned char*)lds;
    int tid = threadIdx.x; asm volatile("" : "+v"(tid));
    const int lane = tid & 63, wid = __builtin_amdgcn_readfirstlane(tid >> 6), wt = wid & 3, wch = wid >> 2, l31 = lane & 31, h2 = lane >> 5;
    bf16_t* PX = (bf16_t*)(p.ws + OFF_PX);
    float* SUMA = (float*)(p.ws + OFF_SUM); float* SUMB = SUMA + 8 * 64 * 1024;
    const float* sp = (const float*)(p.ws + OFF_SP);
    LAS float* SUMS = (LAS float*)(l3 + R_SUMS);
    LAS float* CAR = (LAS float*)(l3 + R_CAR);
    for (int strip = blockIdx.x; strip < 256; strip += gridDim.x) {
        const int hb = strip & 7, jj = strip >> 3, b = jj >> 2, ck0 = (jj & 3) * 16;
        __syncthreads();
        {
            const bf16_t* wg = (const bf16_t*)(p.ws + OFF_WGT) + hb * 256 * 128;
            const unsigned woff = (unsigned)(((tid >> 4) * 128 + (tid & 15) * 8) * 2), wlds = (unsigned)(R_WG + (tid >> 4) * RS + (tid & 15) * 16);
#pragma unroll
            for (int i = 0; i < 8; ++i) {
                const u32x4 v = *(const u32x4*)((const char*)wg + woff + i * 8192u);
                *(LAS u32x4*)(l3 + wlds + i * (32 * RS)) = v;
            }
        }
        unsigned bxc[2], bzz[2];
#pragma unroll
        for (int nt = 0; nt < 2; ++nt) {
            bxc[nt] = R_XC + (wt * 32 + 4 * h2) * RS + (wch * 64 + nt * 32 + l31) * 2;
            bzz[nt] = R_Z + (wt * 32 + 4 * h2) * 256 + (wch * 64 + nt * 32 + l31) * 2;
        }
        float ba[2], bxv[2], spl[2];
#pragma unroll
        for (int nt = 0; nt < 2; ++nt) { const int ch = hb * 128 + wch * 64 + nt * 32 + l31; ba[nt] = p.b_a[ch]; bxv[nt] = p.b_x[ch]; spl[nt] = sp[ch] * 1.4426950408889634f; }
        if (PASS2) {
            if (tid < 128) {
                const int ch = hb * 128 + tid; float h = 0.f;
                for (int c0 = 0; c0 < ck0; c0 += 16) {
                    float av[16], bv[16];
#pragma unroll
                    for (int i = 0; i < 16; ++i) { const size_t o = (size_t)(b * 64 + c0 + i) * 1024 + ch; av[i] = SUMA[o]; bv[i] = SUMB[o]; }
#pragma unroll
                    for (int i = 0; i < 16; ++i) h = av[i] * h + bv[i];
                }
                CAR[tid] = h;
            }
        }
        u32x4 xr[7], zr[4]; int posv = 1;
        const unsigned xoff = (unsigned)(((tid >> 4) * 4 * NPX + (tid & 15) * 8) * 2);
        const unsigned zoff = (unsigned)(((tid >> 4) * NPX + CX_ZR + (tid & 15) * 8) * 2);
        auto load_tile = [&](int tokb, int tt0) {
            asm volatile("" : "+s"(tokb));
            const char* tb = (const char*)(PX + (size_t)tokb * NPX + hb * 128);
            const int tq = tid >> 4;
#pragma unroll
            for (int i = 0; i < 7; ++i) {
                if (tt0 + tq * 4 + i - 3 >= 0) xr[i] = *(const u32x4*)(tb + (ptrdiff_t)(i - 3) * (NPX * 2) + xoff);
                else xr[i] = (u32x4){0u, 0u, 0u, 0u};
            }
            if (PASS2) {
#pragma unroll
                for (int i = 0; i < 4; ++i) zr[i] = *(const u32x4*)(tb + (size_t)i * (32 * NPX * 2) + zoff);
            }
            posv = p.pos[tokb + wt * 32 + l31];
        };
        load_tile(b * SEQ + ck0 * 128, ck0 * 128);
        for (int ci = 0; ci < 16; ++ci) {
            const int ck = ck0 + ci, t0 = ck * 128, tokbase = b * SEQ + t0;
            {
                const int ch8 = tid & 15, tq = tid >> 4;
                const float* cwp = p.conv_w + hb * 128 + ch8 * 8;
                f32x4 cw[4][2], cb[2];
#pragma unroll
                for (int k = 0; k < 4; ++k) { cw[k][0] = *(const f32x4*)(cwp + k * 1024); cw[k][1] = *(const f32x4*)(cwp + k * 1024 + 4); }
                cb[0] = *(const f32x4*)(p.conv_b + hb * 128 + ch8 * 8); cb[1] = *(const f32x4*)(p.conv_b + hb * 128 + ch8 * 8 + 4);
#pragma unroll
                for (int o = 0; o < 4; ++o) {
                    float y[8];
#pragma unroll
                    for (int e = 0; e < 8; ++e) y[e] = cb[e >> 2][e & 3];
#pragma unroll
                    for (int k = 0; k < 4; ++k) {
                        const u32x4 xv = xr[o + k];
#pragma unroll
                        for (int e2 = 0; e2 < 4; ++e2) {
                            const unsigned w = xv[e2];
                            y[2 * e2] += cw[k][(2 * e2) >> 2][(2 * e2) & 3] * __uint_as_float(w << 16);
                            y[2 * e2 + 1] += cw[k][(2 * e2 + 1) >> 2][(2 * e2 + 1) & 3] * __uint_as_float(w & 0xffff0000u);
                        }
                    }
                    const int tt = tq * 4 + o;
                    u32x4 w; w.x = pk2(y[0], y[1]); w.y = pk2(y[2], y[3]); w.z = pk2(y[4], y[5]); w.w = pk2(y[6], y[7]);
                    *(LAS u32x4*)(l3 + R_XC + tt * RS + ch8 * 16) = w;
                }
            }
            const unsigned rbh = ((unsigned)__ballot(posv == 0)) >> (4 * h2);
            if (PASS2) {
#pragma unroll
                for (int i = 0; i < 4; ++i) *(LAS u32x4*)(l3 + R_Z + (i * 32 + (tid >> 4)) * 256 + (tid & 15) * 16) = zr[i];
            }
            if (ci + 1 < 16) load_tile(tokbase + 128, t0 + 128);
            __syncthreads();
            f32x16 accA[2], accX[2];
#pragma unroll
            for (int nt = 0; nt < 2; ++nt)
#pragma unroll
                for (int r = 0; r < 16; ++r) { accA[nt][r] = 0.f; accX[nt][r] = 0.f; }
            {
                const unsigned abase = R_XC + (wt * 32 + l31) * RS + h2 * 16;
                const unsigned bbase = R_WG + (wch * 64 + l31) * RS + h2 * 16;
#pragma unroll
                for (int ks = 0; ks < 8; ++ks) {
                    const unsigned kb = (unsigned)(ks * 32);
                    const bf16x8 af = *(const LAS bf16x8*)(l3 + abase + kb);
#pragma unroll
                    for (int nt = 0; nt < 2; ++nt) {
                        const bf16x8 bA = *(const LAS bf16x8*)(l3 + bbase + nt * 32 * RS + kb);
                        const bf16x8 bX = *(const LAS bf16x8*)(l3 + bbase + (128 + nt * 32) * RS + kb);
                        accA[nt] = __builtin_amdgcn_mfma_f32_32x32x16_bf16(af, bA, accA[nt], 0, 0, 0);
                        accX[nt] = __builtin_amdgcn_mfma_f32_32x32x16_bf16(af, bX, accX[nt], 0, 0, 0);
                    }
                }
            }
#pragma unroll
            for (int nt = 0; nt < 2; ++nt)
#pragma unroll
                for (int r = 0; r < 16; ++r) {
                    const float xcv = bf2f(*(const LAS bf16_t*)(l3 + bxc[nt] + ((r & 3) + 8 * (r >> 2)) * RS));
                    const float rr = fsig(accA[nt][r] + ba[nt]), ii = fsig(accX[nt][r] + bxv[nt]);
                    float a = __builtin_amdgcn_exp2f(spl[nt] * rr);
                    float mult = __builtin_amdgcn_sqrtf(fmaxf(1.0f - a * a, 0.f));
                    const bool rst = (rbh >> ((r & 3) + 8 * (r >> 2))) & 1u;
                    a = rst ? 0.f : a; mult = rst ? 1.f : mult;
                    accA[nt][r] = a; accX[nt][r] = mult * ii * xcv;
                }
            float loA[2][4], loB[2][4], hiA[2][4], hiB[2][4];
#pragma unroll
            for (int nt = 0; nt < 2; ++nt)
#pragma unroll
                for (int s4 = 0; s4 < 4; ++s4) {
                    float A = 1.f, B = 0.f;
#pragma unroll
                    for (int r4 = 0; r4 < 4; ++r4) { const float a = accA[nt][4 * s4 + r4]; B = a * B + accX[nt][4 * s4 + r4]; A *= a; }
                    const float pA = __shfl_xor(A, 32), pB = __shfl_xor(B, 32);
                    loA[nt][s4] = h2 ? pA : A; loB[nt][s4] = h2 ? pB : B; hiA[nt][s4] = h2 ? A : pA; hiB[nt][s4] = h2 ? B : pB;
                }
#pragma unroll
            for (int nt = 0; nt < 2; ++nt) {
                float At = 1.f, Bt = 0.f;
#pragma unroll
                for (int s4 = 0; s4 < 4; ++s4) { Bt = loA[nt][s4] * Bt + loB[nt][s4]; At *= loA[nt][s4]; Bt = hiA[nt][s4] * Bt + hiB[nt][s4]; At *= hiA[nt][s4]; }
                if (h2 == 0) { const int cl = wch * 64 + nt * 32 + l31; SUMS[(wt * 128 + cl) * 2] = At; SUMS[(wt * 128 + cl) * 2 + 1] = Bt; }
            }
            __syncthreads();
            if (!PASS2) {
                if (tid < 128) {
                    float A = 1.f, B = 0.f;
#pragma unroll
                    for (int w = 0; w < 4; ++w) { const float a = SUMS[(w * 128 + tid) * 2], bb = SUMS[(w * 128 + tid) * 2 + 1]; B = a * B + bb; A *= a; }
                    const size_t o = (size_t)(b * 64 + ck) * 1024 + hb * 128 + tid;
                    SUMA[o] = A; SUMB[o] = B;
                }
                __syncthreads();
            } else {
#pragma unroll
                for (int nt = 0; nt < 2; ++nt) {
                    const int cl = wch * 64 + nt * 32 + l31;
                    float H = CAR[cl];
                    for (int w = 0; w < wt; ++w) H = SUMS[(w * 128 + cl) * 2] * H + SUMS[(w * 128 + cl) * 2 + 1];
#pragma unroll
                    for (int s4 = 0; s4 < 4; ++s4) {
                        const float Hlo = loA[nt][s4] * H + loB[nt][s4];
                        float Hs = h2 ? Hlo : H;
                        H = hiA[nt][s4] * Hlo + hiB[nt][s4];
#pragma unroll
                        for (int r4 = 0; r4 < 4; ++r4) {
                            const int r = 4 * s4 + r4;
                            Hs = accA[nt][r] * Hs + accX[nt][r];
                            const float z = bf2f(*(const LAS bf16_t*)(l3 + bzz[nt] + ((r & 3) + 8 * (r >> 2)) * 256));
                            *(LAS bf16_t*)(l3 + bxc[nt] + ((r & 3) + 8 * (r >> 2)) * RS) = f2bf(Hs * z * fsig(z));
                        }
                    }
                }
                __syncthreads();
#pragma unroll
                for (int i = 0; i < 4; ++i) {
                    const int tt = i * 32 + (tid >> 4), c16 = tid & 15;
                    const u32x4 v = *(const LAS u32x4*)(l3 + R_XC + tt * RS + c16 * 16);
                    *(u32x4*)(PX + (size_t)(tokbase + tt) * NPX + CX_ZR + hb * 128 + c16 * 8) = v;
                }
                if (tid < 128) {
                    float H = CAR[tid];
#pragma unroll
                    for (int w = 0; w < 4; ++w) H = SUMS[(w * 128 + tid) * 2] * H + SUMS[(w * 128 + tid) * 2 + 1];
                    CAR[tid] = H;
                }
                __syncthreads();
            }
        }
    }
}


typedef short s16x4 __attribute__((ext_vector_type(4)));
DI unsigned off_b(unsigned row, unsigned ch) { return 256u * row + 16u * (ch ^ (((row & 3u) << 2) | ((row >> 2) & 3u))); }
constexpr int AT_KV = 0, AT_LS = 98304, AT_STG = 100352, STG_RS = 144;

template <int MODE> DI void phase_attn(const Params& p, unsigned char* lds) {
    LAS unsigned char* l3 = (LAS unsigned char*)lds;
    int tid = threadIdx.x; asm volatile("" : "+v"(tid));
    const int lane = tid & 63, w = __builtin_amdgcn_readfirstlane(tid >> 6), l31 = lane & 31, h2 = lane >> 5;
    bf16_t* PX = (bf16_t*)(p.ws + OFF_PX);
    const bf16_t* QH = (const bf16_t*)(p.ws + OFF_QH);
    constexpr size_t SEC_K = (size_t)M * 1024, SEC_V = (size_t)2 * M * 1024;
    bf16_t* O3 = (bf16_t*)p.out; bf16_t* O2 = O3 + (size_t)M * 1024;
    float* LSE3 = (float*)(p.ws + OFF_LSE); float* LSE2 = LSE3 + (size_t)M * 8;
    LAS float* wls = (LAS float*)(l3 + AT_LS) + w * 32;
    const unsigned stg = AT_STG + w * (32 * STG_RS);
    constexpr int NII = (MODE == 0) ? 2 : 1;
    const int total = 64 * 32 * NII;
    const int kk = tid >> 4, c16 = tid & 15;
    const float NEG = -__builtin_inff();
    u32x4 pre[12];
    bf16x8 qf[8];
    int L = blockIdx.x;
    auto decode = [&](int L_, int& b, int& h, int& dil, int& r, int& blk) {
        const int xcd = L_ & 7, idx = (L_ >> 3) & 31, rnd = L_ >> 8;
        const int bh = xcd + 8 * (rnd / NII), ii = rnd % NII, it = idx + 32 * ii;
        b = bh >> 3; h = bh & 7;
        if (MODE == 1) { dil = 1; r = 0; blk = it; }
        else if (it < 32) { dil = 16; r = it & 15; blk = it >> 4; }
        else { dil = 4; r = (it - 32) & 3; blk = (it - 32) >> 2; }
    };
    auto prefetch = [&](size_t sec, int b, int h, int dil, int r, int blk) {
        const bf16_t* base = QH + sec + ((ptrdiff_t)(b * 8 + h) * SEQ + (blk * 256 - 128 + kk) * dil + r) * 128 + c16 * 8;
        const ptrdiff_t tstep = (ptrdiff_t)32 * dil * 128;
#pragma unroll
        for (int i = 0; i < 12; ++i) {
            if (blk > 0 || i >= 4) pre[i] = *(const u32x4*)(base + (ptrdiff_t)i * tstep);
        }
    };
    auto stash = [&]() {
#pragma unroll
        for (int i = 0; i < 12; ++i) *(LAS u32x4*)(l3 + AT_KV + i * 8192 + off_b(kk, c16)) = pre[i];
    };
    auto loadq = [&](bf16x8 (&q)[8], int b, int h, int dil, int r, int blk) {
        const bf16_t* qp = QH + ((size_t)(b * 8 + h) * SEQ + (size_t)(blk * 256 + w * 32 + l31) * dil + r) * 128 + h2 * 8;
#pragma unroll
        for (int ks = 0; ks < 8; ++ks) q[ks] = *(const bf16x8*)(qp + ks * 16);
    };
    unsigned kbase[8];
    { const unsigned xk = ((l31 & 3u) << 2) | ((l31 >> 2) & 3u);
#pragma unroll
      for (int ks = 0; ks < 8; ++ks) kbase[ks] = AT_KV + 256u * l31 + 16u * ((unsigned)(2 * ks + h2) ^ xk); }
    unsigned vbase[4][2];
    { const unsigned blkk = (lane >> 4) & 1u, q4 = (lane & 15u) >> 2, pp = lane & 3u;
#pragma unroll
      for (int d = 0; d < 4; ++d)
#pragma unroll
        for (int t = 0; t < 2; ++t) {
            const unsigned row = 8u * t + 4u * h2 + q4, ch = 4u * d + 2u * blkk + (pp >> 1);
            vbase[d][t] = AT_KV + 256u * row + 16u * (ch ^ ((q4 << 2) | ((2u * t + h2) & 3u))) + 8u * (pp & 1u);
        } }
    if (L < total) { int b, h, dil, r, blk; decode(L, b, h, dil, r, blk); prefetch(SEC_K, b, h, dil, r, blk); }
    for (; L < total; L += gridDim.x) {
        int b, h, dil, r, blk; decode(L, b, h, dil, r, blk);
        loadq(qf, b, h, dil, r, blk);
        stash();
        __syncthreads();
        prefetch(SEC_V, b, h, dil, r, blk);
        float m = -1e30f, lh = 0.f, alpha[5];
        bf16x8 pf[5][2];
        f32x16 Sa, Sb;
#define AT_QK(J, SV) do { \
            _Pragma("unroll") for (int rr = 0; rr < 16; ++rr) SV[rr] = 0.f; \
            bf16x8 kf[8]; \
            _Pragma("unroll") for (int ks = 0; ks < 8; ++ks) kf[ks] = *(const LAS bf16x8*)(l3 + kbase[ks] + (w + (J)) * 8192); \
            __builtin_amdgcn_sched_barrier(0); \
            _Pragma("unroll") for (int ks = 0; ks < 8; ++ks) SV = __builtin_amdgcn_mfma_f32_32x32x16_bf16(kf[ks], qf[ks], SV, 0, 0, 0); \
        } while (0)
#define AT_SMX(J, SV) do { \
            if (blk == 0 && w + (J) < 4) { _Pragma("unroll") for (int rr = 0; rr < 16; ++rr) SV[rr] = NEG; }        \
            if ((J) == 0) { _Pragma("unroll") for (int rr = 0; rr < 16; ++rr) if (crow(rr, h2) < l31) SV[rr] = NEG; }     \
            if ((J) == 4) { _Pragma("unroll") for (int rr = 0; rr < 16; ++rr) if (crow(rr, h2) > l31) SV[rr] = NEG; }     \
            float tm = SV[0]; \
            _Pragma("unroll") for (int rr = 1; rr < 16; ++rr) tm = fmaxf(tm, SV[rr]); \
            tm = fmaxf(tm, __shfl_xor(tm, 32)); \
            const float mn = fmaxf(m, tm); \
            alpha[J] = __builtin_amdgcn_exp2f(m - mn); m = mn; \
            float ps = 0.f; \
            _Pragma("unroll") for (int rr = 0; rr < 16; ++rr) { SV[rr] = __builtin_amdgcn_exp2f(SV[rr] - mn); ps += SV[rr]; } \
            lh = lh * alpha[J] + ps; \
            _Pragma("unroll") for (int s = 0; s < 2; ++s) { \
                u32x4 wv; wv.x = pk2(SV[8 * s + 0], SV[8 * s + 1]); wv.y = pk2(SV[8 * s + 2], SV[8 * s + 3]); \
                wv.z = pk2(SV[8 * s + 4], SV[8 * s + 5]); wv.w = pk2(SV[8 * s + 6], SV[8 * s + 7]); \
                pf[J][s] = __builtin_bit_cast(bf16x8, wv); } \
        } while (0)
        AT_QK(0, Sa);
        AT_QK(1, Sb); AT_SMX(0, Sa);
        AT_QK(2, Sa); AT_SMX(1, Sb);
        AT_QK(3, Sb); AT_SMX(2, Sa);
        AT_QK(4, Sa); AT_SMX(3, Sb);
        AT_SMX(4, Sa);
#undef AT_QK
#undef AT_SMX
        const float lt = lh + __shfl_xor(lh, 32);
        const float linv = __builtin_amdgcn_rcpf(lt);
        if (h2 == 0) wls[l31] = m + __builtin_amdgcn_logf(lt);
        __syncthreads();
        stash();
        __syncthreads();
        const int Ln = L + gridDim.x;
        if (Ln < total) { int b2, h2_, dil2, r2, blk2; decode(Ln, b2, h2_, dil2, r2, blk2); prefetch(SEC_K, b2, h2_, dil2, r2, blk2); }
#pragma unroll
        for (int hd = 0; hd < 2; ++hd) {
            f32x16 O[2];
#pragma unroll
            for (int dd = 0; dd < 2; ++dd)
#pragma unroll
                for (int rr = 0; rr < 16; ++rr) O[dd][rr] = 0.f;
#pragma unroll
            for (int j = 0; j < 5; ++j) {
                if (!(blk == 0 && w + j < 4)) {
                    if (!__all(alpha[j] == 1.0f)) {
#pragma unroll
                        for (int dd = 0; dd < 2; ++dd)
#pragma unroll
                            for (int rr = 0; rr < 16; ++rr) O[dd][rr] *= alpha[j];
                    }
                    s16x4 tv[2][2][2];
#pragma unroll
                    for (int s = 0; s < 2; ++s)
#pragma unroll
                        for (int dd = 0; dd < 2; ++dd)
#pragma unroll
                            for (int t = 0; t < 2; ++t)
                                tv[s][dd][t] = __builtin_amdgcn_ds_read_tr16_b64_v4i16((LAS s16x4*)(l3 + vbase[hd * 2 + dd][t] + (w + j) * 8192 + s * 4096));
                    __builtin_amdgcn_sched_barrier(0);
                    __builtin_amdgcn_s_setprio(1);
#pragma unroll
                    for (int s = 0; s < 2; ++s)
#pragma unroll
                        for (int dd = 0; dd < 2; ++dd) {
                            const bf16x8 vf = __builtin_shufflevector(tv[s][dd][0], tv[s][dd][1], 0, 1, 2, 3, 4, 5, 6, 7);
                            O[dd] = __builtin_amdgcn_mfma_f32_32x32x16_bf16(vf, pf[j][s], O[dd], 0, 0, 0);
                        }
                    __builtin_amdgcn_s_setprio(0);
                    __builtin_amdgcn_sched_barrier(0);
                }
            }
#pragma unroll
            for (int dd = 0; dd < 2; ++dd)
#pragma unroll
                for (int g = 0; g < 4; ++g) {
                    u32x2 wv; wv.x = pk2(O[dd][4 * g] * linv, O[dd][4 * g + 1] * linv); wv.y = pk2(O[dd][4 * g + 2] * linv, O[dd][4 * g + 3] * linv);
                    *(LAS u32x2*)(l3 + stg + l31 * STG_RS + (dd * 32 + 8 * g + 4 * h2) * 2) = wv;
                }
#pragma unroll
            for (int it = 0; it < 4; ++it) {
                const int q = it * 8 + (lane >> 3), cc = lane & 7;
                const u32x4 o1 = *(const LAS u32x4*)(l3 + stg + q * STG_RS + cc * 16);
                const size_t tok = (size_t)b * SEQ + (size_t)(blk * 256 + w * 32 + q) * dil + r;
                const int col = h * 128 + hd * 64 + cc * 8;
                if (MODE == 0) {
                    bf16_t* Ob = (dil == 16) ? O3 : O2;
                    *(u32x4*)(Ob + tok * 1024 + col) = o1;
                } else {
                    const u32x4 o2 = *(const u32x4*)(O2 + tok * 1024 + col);
                    const u32x4 o3 = *(const u32x4*)(O3 + tok * 1024 + col);
                    bf16_t* zp = PX + tok * NPX + CX_ZA + col;
                    const u32x4 zv = *(const u32x4*)zp;
                    const float e1 = wls[q], e2 = LSE2[tok * 8 + h], e3 = LSE3[tok * 8 + h];
                    const float em = fmaxf(e1, fmaxf(e2, e3));
                    float w1 = __builtin_amdgcn_exp2f(e1 - em), w2 = __builtin_amdgcn_exp2f(e2 - em), w3 = __builtin_amdgcn_exp2f(e3 - em);
                    const float wn = __builtin_amdgcn_rcpf(w1 + w2 + w3); w1 *= wn; w2 *= wn; w3 *= wn;
                    u32x4 res;
#pragma unroll
                    for (int e = 0; e < 4; ++e) {
                        const float a0 = w1 * bflo(o1[e]) + w2 * bflo(o2[e]) + w3 * bflo(o3[e]);
                        const float a1 = w1 * bfhi(o1[e]) + w2 * bfhi(o2[e]) + w3 * bfhi(o3[e]);
                        const float z0 = bflo(zv[e]), z1 = bfhi(zv[e]);
                        res[e] = pk2(a0 * z0 * fsig(z0), a1 * z1 * fsig(z1));
                    }
                    *(u32x4*)zp = res;
                }
            }
        }
        if (MODE == 0) {
            if (h2 == 0) {
                const size_t tok = (size_t)b * SEQ + (size_t)(blk * 256 + w * 32 + l31) * dil + r;
                float* Lb = (dil == 16) ? LSE3 : LSE2;
                Lb[tok * 8 + h] = m + __builtin_amdgcn_logf(lt);
            }
        }
        __syncthreads();
    }
}

DI void phase_final(const Params& p) {
    const int lane = threadIdx.x & 63, wid = threadIdx.x >> 6;
    const float* rowsq = (const float*)(p.ws + OFF_ROWSQ);
    for (int r8 = blockIdx.x; r8 < M / 8; r8 += gridDim.x) {
        const int row = r8 * 8 + wid;
        float* xr = p.out + (size_t)row * D;
        float4 v[4];
#pragma unroll
        for (int i = 0; i < 4; ++i) v[i] = *(const float4*)(xr + i * 256 + lane * 4);
        float ss = (lane < 16) ? rowsq[(size_t)row * 16 + lane] : 0.f;
        ss = wave_sum(ss);
        const float rstd = rsqrtf(ss * (1.0f / D) + 1e-6f);
#pragma unroll
        for (int i = 0; i < 4; ++i) {
            const float4 g = *(const float4*)(p.g_final + i * 256 + lane * 4);
            float4 o; o.x = v[i].x * rstd * g.x; o.y = v[i].y * rstd * g.y; o.z = v[i].z * rstd * g.z; o.w = v[i].w * rstd * g.w;
            *(float4*)(xr + i * 256 + lane * 4) = o;
        }
    }
}


#define XB_TMO      128
#define XB_XCNT(j)  (256  + 64 * (j))
#define XB_XSUB(j)  (1280 + 64 * (j))
#define XB_XGEN(j)  (2304 + 64 * (j))
#define XB_TOP      3328
#define XB_TOPGEN   3392
#define XCD_BAR_WORDS 3456
#define XB_SPIN_CAP (1u << 22)
DI unsigned xb_ld(unsigned* p)              { return __hip_atomic_load(p, __ATOMIC_RELAXED, __HIP_MEMORY_SCOPE_AGENT); }
DI unsigned xb_add(unsigned* p, unsigned v) { return __hip_atomic_fetch_add(p, v, __ATOMIC_RELAXED, __HIP_MEMORY_SCOPE_AGENT); }
DI unsigned xb_xcc_id() { return (unsigned)__builtin_amdgcn_s_getreg((3 << 11) | 20) & 0xFu; }
#define XB_SPIN(cond, bar) do { unsigned _sp = 0; while (cond) { __builtin_amdgcn_s_sleep(1); \
    if ((++_sp & 255u) == 0u) { if (xb_ld(&(bar)[XB_TMO])) break; if (_sp > XB_SPIN_CAP) { atomicAdd(&(bar)[XB_TMO], 1u); break; } } } } while (0)
struct XcdBarrier { unsigned* bar; unsigned x; volatile LAS unsigned* st; };
DI XcdBarrier xcd_barrier_post(unsigned* bar, volatile LAS unsigned* st) {
    XcdBarrier b; b.bar = bar; b.x = xb_xcc_id(); b.st = st;
    if (threadIdx.x == 0) (void)xb_add(&bar[XB_XCNT(b.x)], 1u);
    return b;
}
DI void xcd_barrier_complete(unsigned* bar, unsigned x, unsigned& nloc, unsigned& nx) {
    const unsigned G = gridDim.x * gridDim.y * gridDim.z;
    unsigned sum, cnt, mine, sp = 0u;
    for (;;) {
        sum = 0u; cnt = 0u; mine = 0u;
#pragma unroll
        for (unsigned j = 0; j < 16; ++j) { const unsigned c = xb_ld(&bar[XB_XCNT(j)]); sum += c; cnt += (c > 0u) ? 1u : 0u; mine = (j == x) ? c : mine; }
        if (sum == G) break;
        __builtin_amdgcn_s_sleep(1);
        if ((++sp & 255u) == 0u) { if (xb_ld(&bar[XB_TMO])) break; if (sp > XB_SPIN_CAP) { atomicAdd(&bar[XB_TMO], 1u); break; } }
    }
    nloc = mine > 0u ? mine : 1u; nx = cnt > 0u ? cnt : 1u;
}
DI void xcd_barrier(const XcdBarrier& b) {
    asm volatile("s_waitcnt vmcnt(0)" ::: "memory");
    __syncthreads();
    if (threadIdx.x == 0) {
        unsigned* bar = b.bar;
        __builtin_amdgcn_s_waitcnt(0);
        unsigned nloc = b.st[0], nx = b.st[1];
        if (nloc == 0u) { xcd_barrier_complete(bar, b.x, nloc, nx); b.st[0] = nloc; b.st[1] = nx; }
        const unsigned old = xb_add(&bar[XB_XSUB(b.x)], 1u);
        const unsigned gen = old / nloc;
        if (old + 1u == (gen + 1u) * nloc) {
            __builtin_amdgcn_fence(__ATOMIC_RELEASE, "agent");
            asm volatile("s_waitcnt vmcnt(0)" ::: "memory");
            const unsigned og = xb_add(&bar[XB_TOP], 1u);
            const unsigned tg = og / nx;
            if (og + 1u == (tg + 1u) * nx) xb_add(&bar[XB_TOPGEN], 1u);
            else XB_SPIN(xb_ld(&bar[XB_TOPGEN]) == tg, bar);
            __builtin_amdgcn_fence(__ATOMIC_ACQUIRE, "agent");
            xb_add(&bar[XB_XGEN(b.x)], 1u);
            asm volatile("s_waitcnt vmcnt(0)" ::: "memory");
        } else {
            XB_SPIN(xb_ld(&bar[XB_XGEN(b.x)]) == gen, bar);
            __builtin_amdgcn_fence(__ATOMIC_ACQUIRE, "agent");
            asm volatile("s_waitcnt vmcnt(0)" ::: "memory");
        }
    }
    __syncthreads();
}

constexpr int N_PHASES = 8;
__global__ void __launch_bounds__(512) mega(Params p) {
    extern __shared__ __attribute__((aligned(16))) unsigned char lds[];
    LAS unsigned char* l3 = (LAS unsigned char*)lds;
    float* smf = (float*)lds;
    const int G = gridDim.x, c = blockIdx.x;
    bf16_t* PX = (bf16_t*)(p.ws + OFF_PX); bf16_t* QH = (bf16_t*)(p.ws + OFF_QH); bf16_t* KH = (bf16_t*)(p.ws + OFF_KH);
    const int lo = p.ph_lo, hi = p.ph_hi;
    volatile LAS unsigned* xst = (volatile LAS unsigned*)(l3 + LDS_BYTES - 16);
    if (threadIdx.x == 0) { xst[0] = 0u; xst[1] = 0u; }
    __syncthreads();
    XcdBarrier xbar = xcd_barrier_post((unsigned*)(p.ws + OFF_BAR), xst);
#define IN(k) (lo <= (k) && (k) < hi)
#define SYNC(k) do { if (IN(k) && IN((k) + 1)) xcd_barrier(xbar); } while (0)
    if (IN(0)) phase_prologue(p, smf);
    SYNC(0);
    if (IN(1)) phase_h(p);
    SYNC(1);
    if (IN(2)) {
        pg8::TileSched S; S.init(M, NP, G, c, 1, p.ws + OFF_H, nullptr, D, p.ws + OFF_WINT, nullptr, 1024);
        EpiProj E{PX, QH, (const float*)(p.ws + OFF_ROPE), l3 + 131072};
        pg8::gemm_phase<EpiProj, pg8::TileSched, true, true>(l3, D, 1024, 16, S, E);
    }
    SYNC(2);
    if (IN(3)) { phase_rnn<false>(p, lds); phase_attn<0>(p, lds); }
    SYNC(3);
    if (IN(4)) { phase_rnn<true>(p, lds); phase_attn<1>(p, lds); }
    SYNC(4);
    if (IN(5)) {
        pg8::TileSched S; S.init(M, 2048, G, c, 1, p.ws + OFF_H, nullptr, D, p.ws + OFF_WGL, nullptr, 1024);
        EpiGate E{KH, p.b_gate};
        pg8::gemm_phase<EpiGate, pg8::TileSched, true, true>(l3, D, 1024, 16, S, E);
    }
    SYNC(5);
    if (IN(6)) {
        pg8::TileSched S; S.init(M, 1024, G, c, 2, PX + CX_ZR, PX + CX_ZA, NPX, p.ws + OFF_WR, p.ws + OFF_WA, 1024);
        EpiMerged E{QH};
        pg8::gemm_phase<EpiMerged, pg8::TileSched, true, true>(l3, NPX, 1024, 16, S, E);
    }
    SYNC(6);
    if (IN(7)) {
        pg8::TileSched S; S.init(M, 1024, G, c, 1, QH, nullptr, 1024, p.ws + OFF_WO, nullptr, 1024);
        EpiOut E{p.x, (const float*)(p.ws + OFF_MOD), p.g_final, p.out, (float*)(p.ws + OFF_ROWSQ), (unsigned*)(p.ws + OFF_BAR + 16384), l3 + 131072};
        pg8::gemm_phase<EpiOut, pg8::TileSched, true, true>(l3, 1024, 1024, 16, S, E);
    }
#undef IN
#undef SYNC
}

extern "C" void kernel_launch(void* const* d_in, const int* in_sizes, int n_in, void* d_out, int out_size, void* d_ws, size_t ws_size,
                              hipStream_t stream) {
    static int grid_blocks = 0;
    if (grid_blocks == 0) {
        if (ws_size < OFF_END) { fprintf(stderr, "workspace too small: %zu < %zu\n", ws_size, (size_t)OFF_END); grid_blocks = -1; return; }
        int dev = 0, cus = 0, per_cu = 0;
        (void)hipGetDevice(&dev);
        (void)hipDeviceGetAttribute(&cus, hipDeviceAttributeMultiprocessorCount, dev);
        (void)hipFuncSetAttribute((const void*)mega, hipFuncAttributeMaxDynamicSharedMemorySize, LDS_BYTES);
        (void)hipOccupancyMaxActiveBlocksPerMultiprocessor(&per_cu, (const void*)mega, 512, LDS_BYTES);
        if (per_cu < 1) { fprintf(stderr, "occupancy query says %d blocks per CU\n", per_cu); per_cu = 1; }
        grid_blocks = cus;
        fprintf(stderr, "mega: cus %d per_cu %d grid %d\n", cus, per_cu, grid_blocks);
    }
    if (grid_blocks < 0) return;
    Params p{};
    p.x = (const float*)d_in[0]; p.c = (const float*)d_in[1]; p.pos = (const int*)d_in[2]; p.g_norm = (const float*)d_in[3];
    p.w_mod = (const float*)d_in[4]; p.b_mod = (const float*)d_in[5]; p.w_in = (const float*)d_in[6]; p.b_gate = (const float*)d_in[7];
    p.conv_w = (const float*)d_in[8]; p.conv_b = (const float*)d_in[9]; p.w_a = (const float*)d_in[10]; p.b_a = (const float*)d_in[11];
    p.w_x = (const float*)d_in[12]; p.b_x = (const float*)d_in[13]; p.lam = (const float*)d_in[14]; p.w_out_rnn = (const float*)d_in[15];
    p.w_out_attn = (const float*)d_in[16]; p.w_o = (const float*)d_in[17]; p.g_final = (const float*)d_in[18];
    p.out = (float*)d_out; p.ws = (char*)d_ws;
    for (int i = 0; i < 16; ++i) p.inv_freq[i] = (float)pow(500000.0, -(double)(2 * i) / 32.0);
    p.ph_lo = 0; p.ph_hi = N_PHASES;
    (void)hipMemsetAsync((char*)d_ws + OFF_BAR, 0, BAR_BYTES, stream);
    void* args[] = {&p};
    hipError_t e = hipLaunchCooperativeKernel((const void*)mega, dim3(grid_blocks), dim3(512), args, LDS_BYTES, stream);
    if (e != hipSuccess) fprintf(stderr, "cooperative launch failed: %s (grid %d)\n", hipGetErrorString(e), grid_blocks);
}
```

```cpp
#include <hip/hip_runtime.h>
#include <hip/hip_bf16.h>
#include <hip/hip_cooperative_groups.h>
#include <cstdio>
#include <cstdint>
#include <cmath>
namespace cg = cooperative_groups;

typedef unsigned short bf16_t;
#define DI __device__ __forceinline__
#define LAS __attribute__((address_space(3)))
typedef short bf16x8 __attribute__((ext_vector_type(8)));
typedef float f32x4 __attribute__((ext_vector_type(4)));
typedef unsigned u32x2 __attribute__((ext_vector_type(2)));
typedef unsigned u32x4 __attribute__((ext_vector_type(4)));

constexpr int D = 1024, BATCH = 8, SEQ = 8192, M = BATCH * SEQ;
constexpr int NP = 6144;
constexpr size_t SECN = (size_t)M * 1024;
constexpr size_t PXS_XR = 0, PXS_ZR = SECN, PXS_ZA = 2 * SECN;
DI size_t hmrow(int b, int hb, size_t s) { return ((size_t)(b * 8 + hb) * SEQ + s) * 128; }
constexpr float QSCALE = 0.08838834764831845f * 1.4426950408889634f;
constexpr int LDS_BYTES = 163840;

constexpr size_t OFF_PX = 0;
constexpr size_t OFF_QH = OFF_PX + 3 * (size_t)M * 1024 * 2;
constexpr size_t OFF_KH = OFF_QH + (size_t)M * 1024 * 2;
constexpr size_t OFF_VH = OFF_KH + (size_t)M * 1024 * 2;
constexpr size_t OFF_H = OFF_VH + (size_t)M * 1024 * 2;
constexpr size_t OFF_WINT = OFF_H + (size_t)M * D * 2;
constexpr size_t OFF_WGL = OFF_WINT + (size_t)6144 * 1024 * 2;
constexpr size_t OFF_WR = OFF_WGL + (size_t)2048 * 1024 * 2;
constexpr size_t OFF_WA = OFF_WR + (size_t)1024 * 1024 * 2;
constexpr size_t OFF_WO = OFF_WA + (size_t)1024 * 1024 * 2;
constexpr size_t OFF_WGT = OFF_WO + (size_t)1024 * 1024 * 2;
constexpr size_t OFF_MOD = OFF_WGT + (size_t)8 * 256 * 128 * 2;
constexpr size_t OFF_SP = OFF_MOD + 131072;
constexpr size_t OFF_ROPE = OFF_SP + 4096;
constexpr size_t OFF_SUM = OFF_ROPE + (size_t)M * 16 * 8;
constexpr size_t OFF_LSE = OFF_SUM + (size_t)2 * 8 * 64 * 1024 * 4;
constexpr size_t OFF_ROWSQ = OFF_LSE + (size_t)2 * M * 8 * 4;
constexpr size_t OFF_BAR = OFF_ROWSQ + (size_t)M * 16 * 4;
constexpr size_t BAR_BYTES = 16384 + 65536;
constexpr int MOD_CNT_WORD = 3600;
constexpr size_t OFF_END = OFF_BAR + BAR_BYTES;

struct Params {
    const float* x; const float* c; const int* pos; const float* g_norm; const float* w_mod; const float* b_mod;
    const float* w_in; const float* b_gate; const float* conv_w; const float* conv_b; const float* w_a; const float* b_a;
    const float* w_x; const float* b_x; const float* lam; const float* w_out_rnn; const float* w_out_attn; const float* w_o;
    const float* g_final; float* out; char* ws;
    float inv_freq[16];
    int ph_lo, ph_hi;
};

DI int lane_id() { int r; asm volatile("v_mbcnt_lo_u32_b32 %0, -1, 0\n\tv_mbcnt_hi_u32_b32 %0, -1, %0" : "=v"(r)); return r; }
#define TIDX(wv) ((wv) * 64 + lane_id())
DI float bf2f(bf16_t v) { return __uint_as_float(((unsigned)v) << 16); }
DI bf16_t f2bf(float f) { unsigned u = __float_as_uint(f); u += 0x7fffu + ((u >> 16) & 1u); return (bf16_t)(u >> 16); }
typedef __bf16 bf16x2_t __attribute__((ext_vector_type(2)));
typedef float f32x2_t __attribute__((ext_vector_type(2)));
DI unsigned pk2(float lo, float hi) { const f32x2_t v = {lo, hi}; return __builtin_bit_cast(unsigned, __builtin_convertvector(v, bf16x2_t)); }
DI float bflo(unsigned w) { return __uint_as_float(w << 16); }
DI float bfhi(unsigned w) { return __uint_as_float(w & 0xffff0000u); }
DI float sigmoidf_(float v) { return 1.0f / (1.0f + __expf(-v)); }
DI float siluf_(float v) { return v / (1.0f + __expf(-v)); }
DI float fsig(float v) { return __builtin_amdgcn_rcpf(1.0f + __builtin_amdgcn_exp2f(-1.4426950408889634f * v)); }
DI float wave_sum(float v) {
#pragma unroll
    for (int o = 32; o >= 1; o >>= 1) v += __shfl_xor(v, o);
    return v;
}

namespace pg8 {
constexpr int BM = 256, BK = 64, HALF = 128, HTB = HALF * BK * 2, STAGE_BYTES = 8 * HTB, NXCD = 8, WGM = 8;
DI int lds_byte(int r, int c) { const int st = (r >> 4) * 2 + (c >> 5), rr = r & 15, cc = c & 31, ob = rr * 64 + cc * 2; return st * 1024 + (ob ^ (((ob >> 9) & 1) << 5)); }
DI void stage_rc(int b, int& R, int& C) { const int st = b / 1024, sb = b % 1024, swz = sb ^ (((sb >> 9) & 1) << 5); R = (st >> 1) * 16 + swz / 64; C = (st & 1) * 32 + (swz % 64) / 2; }

DI int perm32(int rho) { const int n = rho >> 4, i = rho & 15; return 8 * (i >> 2) + 4 * n + (i & 3); }
struct Unit { int pm, pn, sub; const char* a; const char* b; };

struct TileSched {
    int nM, nN, nwg, G, c, nsub, hmA; const char* A0; const char* A1; const char* B0; const char* B1; size_t tstepA, tstepB;
    DI void init(int M_, int N_, int G_, int c_, int nsub_, const void* a0, const void* a1, size_t tstepA_, int hmA_, const void* b0, const void* b1, int ldb) {
        nM = M_ / BM; nN = N_ / BM; nwg = nM * nN; G = G_; c = c_; nsub = nsub_; hmA = hmA_;
        A0 = (const char*)a0; A1 = (const char*)a1; B0 = (const char*)b0; B1 = (const char*)b1;
        tstepA = tstepA_; tstepB = (size_t)BM * ldb * 2;
    }
    DI bool next(int i, Unit& u) const {
        const int ti = (nsub == 2) ? (i >> 1) : i, sub = (nsub == 2) ? (i & 1) : 0;
        const long L = (long)ti * G + c; if (L >= nwg) return false;
        int wgid = (int)L; { const int q = nwg / NXCD, r = nwg % NXCD, xcd = wgid % NXCD, off = wgid / NXCD; wgid = (xcd < r ? xcd * (q + 1) : r * (q + 1) + (xcd - r) * q) + off; }
        const int nig = WGM * nN, gid = wgid / nig, fm = gid * WGM, gsz = (nM - fm) < WGM ? (nM - fm) : WGM;
        u.pm = fm + ((wgid % nig) % gsz); u.pn = (wgid % nig) / gsz; u.sub = sub;
        u.a = (sub ? A1 : A0) + (hmA ? hmrow(u.pm >> 5, 0, (size_t)(u.pm & 31) * 256) * 2 : (size_t)u.pm * tstepA); u.b = (sub ? B1 : B0) + (size_t)u.pn * tstepB; return true;
    }
};

template <class Epi, class Sched, bool ALIGN_EPI, bool SP2>
DI void gemm_phase(LAS unsigned char* lds, const int lda, const int ldb, const int nt, const Sched& S, const Epi& E, const int wv, const size_t kstepA, const size_t kstep2A) {
    const int wid = wv, lane = lane_id(), tid = wid * 64 + lane, wr = wid >> 2, wc = wid & 3, fr = lane & 15, fq = lane >> 4;
    unsigned voffA[2], voffB[2];
#pragma unroll
    for (int i = 0; i < 2; ++i) { int R, C; stage_rc(tid * 16 + i * 8192, R, C); const int Rb = Epi::BADJ ? (R >> 5) * 64 + perm32(R & 31) : (R & ~31) + perm32(R & 31); voffA[i] = (unsigned)(R * lda + C) * 2u; voffB[i] = (unsigned)(Rb * ldb + C) * 2u; }
    const size_t kstep = (size_t)(BK * 2);
    const size_t hstepA = (size_t)HALF * lda * 2, hstepB = (size_t)(Epi::BADJ ? 32 : HALF) * ldb * 2;
    const unsigned ldsw = (unsigned)wid * 1024u;
    const int aoff = lds_byte(wr * 64 + fr, fq * 8), boff = lds_byte(wc * 32 + fr, fq * 8);
#define PG8_SA(b, h) (((b) * 2 + (h)) * HTB)
#define PG8_SB(b, h) ((4 + (b) * 2 + (h)) * HTB)
#define PG8_STAGE(bufoff, gbase, voff) do { _Pragma("unroll") for (int _i = 0; _i < 2; ++_i) \
        __builtin_amdgcn_global_load_lds((const unsigned*)((const char*)(gbase) + (voff)[_i]), (LAS unsigned*)(lds + (bufoff) + ldsw + _i * 8192), 16, 0, 0); } while (0)
#define PG8_LDA(dst, b, h) do { _Pragma("unroll") for (int m = 0; m < 4; ++m) _Pragma("unroll") for (int k = 0; k < 2; ++k) dst[m][k] = *(const LAS bf16x8*)(lds + PG8_SA(b, h) + aoff + m * 2048 + k * 1024); } while (0)
#define PG8_LDB(dst, b, h) do { _Pragma("unroll") for (int n = 0; n < 2; ++n) _Pragma("unroll") for (int k = 0; k < 2; ++k) dst[n][k] = *(const LAS bf16x8*)(lds + PG8_SB(b, h) + boff + n * 2048 + k * 1024); } while (0)
#define PG8_MMA(ai, bj, At, Bt) do { __builtin_amdgcn_s_setprio(1); _Pragma("unroll") for (int m = 0; m < 4; ++m) _Pragma("unroll") for (int n = 0; n < 2; ++n) _Pragma("unroll") for (int k = 0; k < 2; ++k) \
        acc[ai][bj][m][n] = __builtin_amdgcn_mfma_f32_16x16x32_bf16(Bt[n][k], At[m][k], acc[ai][bj][m][n], 0, 0, 0); __builtin_amdgcn_s_setprio(0); } while (0)
#define PG8_WAIT_V(n) asm volatile("s_waitcnt vmcnt(" #n ")" ::: "memory")
#define PG8_WAIT_L(n) asm volatile("s_waitcnt lgkmcnt(" #n ")" ::: "memory")
#define PG8_WAIT_V8R(flag) do { \
        if constexpr (Epi::NST == 16) asm volatile("s_cmp_lg_u32 %0, 0\n\ts_cbranch_scc0 .Lnr%=\n\ts_waitcnt vmcnt(24)\n\ts_branch .Ldn%=\n.Lnr%=:\n\ts_waitcnt vmcnt(8)\n.Ldn%=:" :: "s"(flag) : "memory", "scc"); \
        else if constexpr (Epi::NST == 32) asm volatile("s_cmp_lg_u32 %0, 0\n\ts_cbranch_scc0 .Lnr%=\n\ts_waitcnt vmcnt(40)\n\ts_branch .Ldn%=\n.Lnr%=:\n\ts_waitcnt vmcnt(8)\n.Ldn%=:" :: "s"(flag) : "memory", "scc"); \
        else PG8_WAIT_V(8); } while (0)
#define PG8_BAR __builtin_amdgcn_s_barrier()
#define PG8_SCHED __builtin_amdgcn_sched_barrier(0)
    Unit cur, nxt; int ui = 0;
    if (!S.next(0, cur)) return;
    f32x4 acc[2][2][4][2];
#pragma unroll
    for (int a = 0; a < 2; ++a)
#pragma unroll
        for (int b = 0; b < 2; ++b)
#pragma unroll
            for (int m = 0; m < 4; ++m)
#pragma unroll
                for (int n = 0; n < 2; ++n) acc[a][b][m][n] = (f32x4){0.f, 0.f, 0.f, 0.f};
    bf16x8 At[4][2], B0[2][2], B1[2][2];
    const char* cA = cur.a; const char* cB = cur.b;
    if constexpr (SP2) {
        PG8_STAGE(PG8_SB(0, 0), cB, voffB); PG8_STAGE(PG8_SB(0, 1), cB + hstepB, voffB); PG8_STAGE(PG8_SA(0, 0), cA, voffA); PG8_STAGE(PG8_SA(0, 1), cA + hstepA, voffA);
        if (wr == 1) PG8_BAR;
        PG8_WAIT_V(2); PG8_BAR;
        PG8_STAGE(PG8_SB(1, 0), cB + kstep, voffB); PG8_STAGE(PG8_SA(1, 0), cA + kstepA, voffA); PG8_STAGE(PG8_SB(1, 1), cB + hstepB + kstep, voffB);
        PG8_WAIT_V(6); PG8_BAR;
    } else {
        PG8_STAGE(PG8_SB(0, 0), cB, voffB); PG8_STAGE(PG8_SA(0, 0), cA, voffA); PG8_STAGE(PG8_SB(0, 1), cB + hstepB, voffB); PG8_STAGE(PG8_SA(0, 1), cA + hstepA, voffA);
        if (wr == 1) PG8_BAR;
        PG8_WAIT_V(4); PG8_BAR;
        PG8_STAGE(PG8_SB(1, 0), cB + kstep, voffB); PG8_STAGE(PG8_SA(1, 0), cA + kstepA, voffA); PG8_STAGE(PG8_SB(1, 1), cB + hstepB + kstep, voffB);
        PG8_WAIT_V(6); PG8_BAR;
    }
    int relax = 0;
    for (;;) {
        const int rs = relax;
        const bool has_next = S.next(ui + 1, nxt);
        const char* nA = has_next ? nxt.a : cA; const char* nB = has_next ? nxt.b : cB;
        for (int t = 0; t < nt; t += 2) {
            const bool last = (t == nt - 2);
            const char* aT = cA + (size_t)(t >> 1) * kstep2A;
            const char* a1 = aT + kstepA;
            const char* a2 = last ? nA : aT + kstep2A; const char* b2 = last ? nB : cB + (size_t)(t + 2) * kstep;
            const char* a3 = a2 + kstepA; const char* b3 = b2 + kstep;
            if constexpr (SP2) {
            const int rf = __builtin_amdgcn_readfirstlane((t == 0) ? rs : 0);
            PG8_LDB(B0, 0, 0); PG8_LDB(B1, 0, 1); PG8_SCHED; PG8_LDA(At, 0, 0); PG8_STAGE(PG8_SA(1, 1), a1 + hstepA, voffA);
            PG8_WAIT_V8R(rf); PG8_WAIT_L(0); PG8_BAR; PG8_MMA(0, 0, At, B0); PG8_MMA(0, 1, At, B1); PG8_BAR; PG8_SCHED;
            PG8_LDA(At, 0, 1); PG8_STAGE(PG8_SB(0, 0), b2, voffB); PG8_STAGE(PG8_SB(0, 1), b2 + hstepB, voffB); PG8_STAGE(PG8_SA(0, 0), a2, voffA);
            PG8_WAIT_V8R(rf); PG8_WAIT_L(0); PG8_BAR; PG8_MMA(1, 0, At, B0); PG8_MMA(1, 1, At, B1); PG8_BAR; PG8_SCHED;
            PG8_LDB(B0, 1, 0); PG8_LDB(B1, 1, 1); PG8_SCHED; PG8_LDA(At, 1, 0); PG8_STAGE(PG8_SA(0, 1), a2 + hstepA, voffA);
            PG8_WAIT_V(8); PG8_WAIT_L(0); PG8_BAR; PG8_MMA(0, 0, At, B0); PG8_MMA(0, 1, At, B1); PG8_BAR; PG8_SCHED;
            PG8_LDA(At, 1, 1); PG8_STAGE(PG8_SB(1, 0), b3, voffB); PG8_STAGE(PG8_SB(1, 1), b3 + hstepB, voffB); PG8_STAGE(PG8_SA(1, 0), a3, voffA);
            PG8_WAIT_V(8); PG8_WAIT_L(0); PG8_BAR; PG8_MMA(1, 0, At, B0); PG8_MMA(1, 1, At, B1); PG8_BAR; PG8_SCHED;
            } else {
            PG8_LDB(B0, 0, 0); PG8_SCHED; PG8_LDA(At, 0, 0); PG8_STAGE(PG8_SA(1, 1), a1 + hstepA, voffA);
            PG8_WAIT_L(8); PG8_BAR; PG8_WAIT_L(0); PG8_MMA(0, 0, At, B0); PG8_BAR; PG8_SCHED;
            PG8_LDB(B1, 0, 1); PG8_STAGE(PG8_SB(0, 0), b2, voffB);
            PG8_BAR; PG8_WAIT_L(0); PG8_MMA(0, 1, At, B1); PG8_BAR;
            PG8_LDA(At, 0, 1); PG8_STAGE(PG8_SA(0, 0), a2, voffA);
            PG8_BAR; PG8_WAIT_L(0); PG8_MMA(1, 0, At, B0); PG8_BAR; PG8_SCHED;
            PG8_STAGE(PG8_SB(0, 1), b2 + hstepB, voffB);
            PG8_WAIT_V(6); PG8_BAR; PG8_MMA(1, 1, At, B1); PG8_BAR;
            PG8_LDB(B0, 1, 0); PG8_SCHED; PG8_LDA(At, 1, 0); PG8_STAGE(PG8_SA(0, 1), a2 + hstepA, voffA);
            PG8_WAIT_L(8); PG8_BAR; PG8_WAIT_L(0); PG8_MMA(0, 0, At, B0); PG8_BAR; PG8_SCHED;
            PG8_LDB(B1, 1, 1); PG8_STAGE(PG8_SB(1, 0), b3, voffB);
            PG8_BAR; PG8_WAIT_L(0); PG8_MMA(0, 1, At, B1); PG8_BAR;
            PG8_LDA(At, 1, 1); PG8_STAGE(PG8_SA(1, 0), a3, voffA);
            PG8_BAR; PG8_WAIT_L(0); PG8_MMA(1, 0, At, B0); PG8_BAR; PG8_SCHED;
            PG8_STAGE(PG8_SB(1, 1), b3 + hstepB, voffB);
            PG8_WAIT_V(6); PG8_BAR; PG8_MMA(1, 1, At, B1); PG8_BAR;
            }
        }
        if constexpr (ALIGN_EPI) { if (wr == 0) PG8_BAR; }
        const int te = lane_id();
        const bool rst = E(acc, cur, wr, wc, te & 15, te >> 4);
        relax = E.stores(cur) ? 1 : 0;
        if (!has_next) break;
        if (rst) {
#pragma unroll
            for (int a = 0; a < 2; ++a)
#pragma unroll
                for (int b = 0; b < 2; ++b)
#pragma unroll
                    for (int m = 0; m < 4; ++m)
#pragma unroll
                        for (int n = 0; n < 2; ++n) acc[a][b][m][n] = (f32x4){0.f, 0.f, 0.f, 0.f};
        }
        cur = nxt; cA = nA; cB = nB; ++ui;
        if constexpr (ALIGN_EPI) { if (wr == 1) PG8_BAR; }
    }
    PG8_WAIT_V(0);
    if constexpr (!ALIGN_EPI) { if (wr == 0) PG8_BAR; }
    PG8_BAR;
#undef PG8_SA
#undef PG8_SB
#undef PG8_STAGE
#undef PG8_LDA
#undef PG8_LDB
#undef PG8_MMA
#undef PG8_WAIT_V
#undef PG8_WAIT_L
#undef PG8_WAIT_V8R
#undef PG8_BAR
#undef PG8_SCHED
}
}

typedef f32x4 Acc[2][2][4][2];

DI unsigned dpp_ror8(unsigned keep, unsigned src, const bool hi_half) {
    return hi_half ? (unsigned)__builtin_amdgcn_update_dpp((int)keep, (int)src, 0x128, 0xf, 0xc, false) : (unsigned)__builtin_amdgcn_update_dpp((int)keep, (int)src, 0x128, 0xf, 0x3, false);
}
DI void pair_rows(u32x4& w0, u32x4& w1) {
    u32x4 a, b;
    a.x = dpp_ror8(w0.x, w1.x, true); a.y = dpp_ror8(w0.y, w1.y, true); a.z = dpp_ror8(w0.z, w1.z, true); a.w = dpp_ror8(w0.w, w1.w, true);
    b.x = dpp_ror8(w1.x, w0.x, false); b.y = dpp_ror8(w1.y, w0.y, false); b.z = dpp_ror8(w1.z, w0.z, false); b.w = dpp_ror8(w1.w, w0.w, false);
    w0 = a; w1 = b;
}
DI void pair_rows(f32x4& v0, f32x4& v1) {
    u32x4 a = __builtin_bit_cast(u32x4, v0), b = __builtin_bit_cast(u32x4, v1);
    pair_rows(a, b);
    v0 = __builtin_bit_cast(f32x4, a); v1 = __builtin_bit_cast(f32x4, b);
}

struct EpiProj {
    bf16_t* PX; bf16_t* QH; const float* tab; LAS unsigned char* tl;
    mutable int tpm;
    static constexpr int NST = 16;
    static constexpr bool BADJ = true;
    DI bool stores(const pg8::Unit&) const { return true; }
    DI bool operator()(Acc& acc, const pg8::Unit& u, int wr, int wc, int fr, int fq) const {
        asm volatile("" : "+v"(fr), "+v"(fq));
        const int sec = u.pn >> 2;
        const bool ropet = (sec == 1 || sec == 2);
        if (ropet && tpm != u.pm) {
            tpm = u.pm;
            const int t = (wr * 4 + wc) * 64 + fq * 16 + fr;
            const int row = t >> 1, half = t & 1;
            const f32x4* src = (const f32x4*)(tab + (size_t)(u.pm * 256 + row) * 32 + half * 16);
            const f32x4 a = src[0], b = src[1], c = src[2], d = src[3];
            u32x4 w0, w1;
            w0.x = pk2(a[0], a[1]); w0.y = pk2(a[2], a[3]); w0.z = pk2(b[0], b[1]); w0.w = pk2(b[2], b[3]);
            w1.x = pk2(c[0], c[1]); w1.y = pk2(c[2], c[3]); w1.z = pk2(d[0], d[1]); w1.w = pk2(d[2], d[3]);
            *(LAS u32x4*)(tl + row * 64 + half * 32) = w0; *(LAS u32x4*)(tl + row * 64 + half * 32 + 16) = w1;
            __syncthreads();
        }
        const bool rope = ropet && (wc & 1) == 0;
        bf16_t* rp0; constexpr size_t rstep = 128;
        {
            const int row = u.pm * 256 + wr * 64 + (fr & 7), cw = wc * 64 + (fr >> 3) * 32 + fq * 8;
            const int dsec = sec == 0 ? 0 : sec >= 4 ? sec - 3 : sec + 2;
            rp0 = PX + (size_t)dsec * SECN + hmrow(row >> 13, (u.pn & 3) * 2 + (wc >> 1), (size_t)(row & (SEQ - 1))) + (cw & 127);
        }
#pragma unroll
        for (int ai = 0; ai < 2; ++ai)
#pragma unroll
            for (int m = 0; m < 4; ++m) {
                const int rl = ai * 128 + wr * 64 + m * 16 + fr;
                u32x4 wst[2];
                u32x4 cs0 = {0u, 0u, 0u, 0u}, cs1 = cs0;
                if (rope) { cs0 = *(const LAS u32x4*)(tl + rl * 64 + (fq & 1) * 32); cs1 = *(const LAS u32x4*)(tl + rl * 64 + (fq & 1) * 32 + 16); }
#pragma unroll
                for (int bj = 0; bj < 2; ++bj) {
                    f32x4 v0 = acc[ai][bj][m][0], v1 = acc[ai][bj][m][1];
                    if (bj == 0 && rope) {
                        f32x4 p0, p1;
#pragma unroll
                        for (int j = 0; j < 4; ++j) { p0[j] = __shfl_xor(v0[j], 32); p1[j] = __shfl_xor(v1[j], 32); }
                        const float sg = (fq & 2) ? 1.0f : -1.0f;
#pragma unroll
                        for (int j = 0; j < 4; ++j) {
                            v0[j] = v0[j] * bflo(cs0[j]) + sg * p0[j] * bfhi(cs0[j]);
                            v1[j] = v1[j] * bflo(cs1[j]) + sg * p1[j] * bfhi(cs1[j]);
                        }
                    }
                    u32x4 w; w.x = pk2(v0[0], v0[1]); w.y = pk2(v0[2], v0[3]); w.z = pk2(v1[0], v1[1]); w.w = pk2(v1[2], v1[3]);
                    wst[bj] = w;
                }
                pair_rows(wst[0], wst[1]);
                bf16_t* rp = rp0 + (size_t)(ai * 128 + m * 16) * rstep;
                __builtin_nontemporal_store(wst[0], (u32x4*)rp);
                __builtin_nontemporal_store(wst[1], (u32x4*)(rp + 8 * rstep));
            }
        return true;
    }
};
struct EpiGate {
    bf16_t* KH; const float* bias;
    static constexpr int NST = 16;
    static constexpr bool BADJ = false;
    DI bool stores(const pg8::Unit&) const { return true; }
    DI bool operator()(Acc& acc, const pg8::Unit& u, int wr, int wc, int fr, int fq) const {
        const int c0 = u.pn * 128 + wc * 32 + fq * 8;
#pragma unroll
        for (int ai = 0; ai < 2; ++ai)
#pragma unroll
            for (int m = 0; m < 4; ++m) {
                bf16_t* rp = KH + ((size_t)((u.pm * 8 + u.pn) * 16 + ai * 8 + wr * 4 + m) * 4 + wc) * 512 + fr * 32 + fq * 8;
                float sr[8], sa[8];
#pragma unroll
                for (int n = 0; n < 2; ++n) {
                    const f32x4 vr = acc[ai][0][m][n] + *(const f32x4*)(bias + c0 + n * 4), va = acc[ai][1][m][n] + *(const f32x4*)(bias + 1024 + c0 + n * 4);
#pragma unroll
                    for (int j = 0; j < 4; ++j) {
                        const float er = 1.0f + __builtin_amdgcn_exp2f(-1.4426950408889634f * vr[j]), ea = 1.0f + __builtin_amdgcn_exp2f(-1.4426950408889634f * va[j]);
                        sa[n * 4 + j] = __builtin_amdgcn_rcpf(ea);
                        sr[n * 4 + j] = ea * __builtin_amdgcn_rcpf(er);
                    }
                }
                u32x4 w; w.x = pk2(sr[0], sr[1]); w.y = pk2(sr[2], sr[3]); w.z = pk2(sr[4], sr[5]); w.w = pk2(sr[6], sr[7]);
                *(u32x4*)rp = w;
                w.x = pk2(sa[0], sa[1]); w.y = pk2(sa[2], sa[3]); w.z = pk2(sa[4], sa[5]); w.w = pk2(sa[6], sa[7]);
                *(u32x4*)(rp + (size_t)M * 1024) = w;
            }
        return true;
    }
};
struct EpiMerged {
    bf16_t* QH;
    static constexpr int NST = 0;
    static constexpr bool BADJ = true;
    DI bool stores(const pg8::Unit&) const { return false; }
    DI bool operator()(Acc& acc, const pg8::Unit& u, int wr, int wc, int fr, int fq) const {
        const size_t goff = (u.sub == 0) ? (size_t)M * 1024 : (size_t)2 * M * 1024;
        bf16_t* rp0 = QH + (size_t)u.pm * (256 * 1024) + (size_t)(u.pn * 4 + wc) * (256 * 64) + (wr * 64 + (fr & 7)) * 64 + (fr >> 3) * 32 + fq * 8;
#pragma unroll
        for (int ai = 0; ai < 2; ++ai) {
            u32x4 gg[4][2];
#pragma unroll
            for (int m = 0; m < 4; ++m) {
                const bf16_t* gp = QH + goff + ((size_t)((u.pm * 8 + u.pn * 2 + (wc >> 1)) * 16 + ai * 8 + wr * 4 + m) * 4 + (wc & 1) * 2) * 512 + fr * 32 + fq * 8;
#pragma unroll
                for (int bj = 0; bj < 2; ++bj) gg[m][bj] = *(const u32x4*)(gp + bj * 512);
            }
#pragma unroll
            for (int m = 0; m < 4; ++m) {
                u32x4 wst[2];
#pragma unroll
                for (int bj = 0; bj < 2; ++bj) {
                    const u32x4 a = gg[m][bj];
                    f32x4 v0 = acc[ai][bj][m][0], v1 = acc[ai][bj][m][1];
                    v0[0] *= bflo(a.x); v0[1] *= bfhi(a.x); v0[2] *= bflo(a.y); v0[3] *= bfhi(a.y);
                    v1[0] *= bflo(a.z); v1[1] *= bfhi(a.z); v1[2] *= bflo(a.w); v1[3] *= bfhi(a.w);
                    if (u.sub == 0) { acc[ai][bj][m][0] = v0; acc[ai][bj][m][1] = v1; }
                    else { wst[bj].x = pk2(v0[0], v0[1]); wst[bj].y = pk2(v0[2], v0[3]); wst[bj].z = pk2(v1[0], v1[1]); wst[bj].w = pk2(v1[2], v1[3]); }
                }
                if (u.sub != 0) {
                    pair_rows(wst[0], wst[1]);
                    bf16_t* rp = rp0 + (ai * 128 + m * 16) * 64;
                    *(u32x4*)rp = wst[0]; *(u32x4*)(rp + 8 * 64) = wst[1];
                }
            }
        }
        return u.sub != 0;
    }
};
struct EpiOut {
    const float* x; const float* mod; const float* gfin; float* out; float* rowsq; unsigned* cnt; LAS unsigned char* sl;
    static constexpr int NST = 0;
    static constexpr bool BADJ = true;
    DI bool stores(const pg8::Unit&) const { return false; }
    DI bool operator()(Acc& acc, const pg8::Unit& u, int wr, int wc, int fr, int fq) const {
        asm volatile("" : "+v"(fr), "+v"(fq));
        const int col0 = u.pn * 256 + wc * 64 + fq * 8;
        const int wid = wr * 4 + wc, lane = fq * 16 + fr;
        LAS float* S = (LAS float*)sl;
        const size_t po = (size_t)(u.pm * 256 + wr * 64 + (fr & 7)) * D + u.pn * 256 + wc * 64 + fq * 8 + (fr >> 3) * 4;
        f32x4 gv[2][2];
        {
            const float* gp = mod + ((u.pm * 256) / SEQ) * 3072 + 2048 + col0;
#pragma unroll
            for (int bj = 0; bj < 2; ++bj)
#pragma unroll
                for (int n = 0; n < 2; ++n) gv[bj][n] = *(const f32x4*)(gp + bj * 32 + n * 4);
        }
#pragma unroll
        for (int ai = 0; ai < 2; ++ai) {
            f32x4 xv[4][2][2];
#pragma unroll
            for (int m = 0; m < 4; ++m) {
                const float* xp = x + po + (size_t)(ai * 128 + m * 16) * D;
#pragma unroll
                for (int bj = 0; bj < 2; ++bj) { xv[m][bj][0] = *(const f32x4*)(xp + bj * 32); xv[m][bj][1] = *(const f32x4*)(xp + bj * 32 + 8 * D); }
            }
#pragma unroll
            for (int m = 0; m < 4; ++m) {
                const int row = u.pm * 256 + ai * 128 + wr * 64 + m * 16 + fr;
                float ss = 0.f;
#pragma unroll
                for (int bj = 0; bj < 2; ++bj) {
                    pair_rows(xv[m][bj][0], xv[m][bj][1]);
#pragma unroll
                    for (int n = 0; n < 2; ++n) {
                        const f32x4 o = xv[m][bj][n] + gv[bj][n] * acc[ai][bj][m][n];
                        ss += o[0] * o[0] + o[1] * o[1] + o[2] * o[2] + o[3] * o[3];
                        acc[ai][bj][m][n] = o;
                    }
                }
                ss += __shfl_xor(ss, 16); ss += __shfl_xor(ss, 32);
                if (fq == 0) __hip_atomic_store(rowsq + (size_t)row * 16 + u.pn * 4 + wc, ss, __ATOMIC_RELAXED, __HIP_MEMORY_SCOPE_AGENT);
            }
        }
        asm volatile("s_waitcnt vmcnt(0)" ::: "memory");
        unsigned* pc = cnt + 64 * u.pm;
        if (lane == 0) __hip_atomic_fetch_add(pc, 1u, __ATOMIC_RELAXED, __HIP_MEMORY_SCOPE_AGENT);
        if (wid == 0) {
            unsigned spins = 0;
            while ((unsigned)__builtin_amdgcn_readfirstlane(__hip_atomic_load(pc, __ATOMIC_RELAXED, __HIP_MEMORY_SCOPE_AGENT)) < 32u) {
                __builtin_amdgcn_s_sleep(2);
                if (++spins > (1u << 24)) break;
            }
            __builtin_amdgcn_fence(__ATOMIC_ACQUIRE, "agent");
            asm volatile("s_waitcnt vmcnt(0)" ::: "memory");
        }
        __syncthreads();
        const int tix = wid * 64 + lane;
        if (tix < 256) {
            const f32x4* sp = (const f32x4*)(rowsq + (size_t)(u.pm * 256 + tix) * 16);
            const f32x4 a = sp[0], b2 = sp[1], c2 = sp[2], d2 = sp[3];
            const float t = (a[0] + a[1] + a[2] + a[3]) + (b2[0] + b2[1] + b2[2] + b2[3]) + (c2[0] + c2[1] + c2[2] + c2[3]) + (d2[0] + d2[1] + d2[2] + d2[3]);
            S[tix] = rsqrtf(t * (1.0f / D) + 1e-6f);
        }
        __syncthreads();
        f32x4 gf[2][2];
#pragma unroll
        for (int bj = 0; bj < 2; ++bj)
#pragma unroll
            for (int n = 0; n < 2; ++n) gf[bj][n] = *(const f32x4*)(gfin + col0 + bj * 32 + n * 4);
#pragma unroll
        for (int ai = 0; ai < 2; ++ai)
#pragma unroll
            for (int m = 0; m < 4; ++m) {
                const int rl = ai * 128 + wr * 64 + m * 16 + fr;
                const float rs = S[rl];
                float* op = out + po + (size_t)(ai * 128 + m * 16) * D;
#pragma unroll
                for (int bj = 0; bj < 2; ++bj) {
                    f32x4 o0 = acc[ai][bj][m][0] * rs * gf[bj][0], o1 = acc[ai][bj][m][1] * rs * gf[bj][1];
                    pair_rows(o0, o1);
                    *(f32x4*)(op + bj * 32) = o0; *(f32x4*)(op + bj * 32 + 8 * D) = o1;
                }
            }
        return true;
    }
};

DI void transpose_tile(const float* src, int lds_, int col0, int k0, bf16_t* dst, int ldd, int n0, float* tile, const int wv) {
    const int tid = TIDX(wv);
    {
        const int k = tid >> 3, n8 = (tid & 7) * 8;
        const float4 a = *(const float4*)(src + (size_t)(k0 + k) * lds_ + col0 + n8);
        const float4 b = *(const float4*)(src + (size_t)(k0 + k) * lds_ + col0 + n8 + 4);
        float* t = tile + k * 65 + n8;
        t[0] = a.x; t[1] = a.y; t[2] = a.z; t[3] = a.w; t[4] = b.x; t[5] = b.y; t[6] = b.z; t[7] = b.w;
    }
    __syncthreads();
    {
        const int n = tid >> 3, k8 = (tid & 7) * 8;
        u32x4 w;
        w.x = pk2(tile[(k8 + 0) * 65 + n], tile[(k8 + 1) * 65 + n]); w.y = pk2(tile[(k8 + 2) * 65 + n], tile[(k8 + 3) * 65 + n]);
        w.z = pk2(tile[(k8 + 4) * 65 + n], tile[(k8 + 5) * 65 + n]); w.w = pk2(tile[(k8 + 6) * 65 + n], tile[(k8 + 7) * 65 + n]);
        *(u32x4*)(dst + (size_t)(n0 + n) * ldd + k0 + k8) = w;
    }
    __syncthreads();
}

DI void transpose_tile4(const float* src, int lds_, int col0, int hstep, int k0, bf16_t* dst, int ldd, int n0, float scale, float* tile, const int wv) {
    const int tid = TIDX(wv);
    {
        const int k = tid >> 3, n8 = (tid & 7) * 8;
        float4 a[4], b[4];
#pragma unroll
        for (int j = 0; j < 4; ++j) {
            const float* sp = src + (size_t)(k0 + k) * lds_ + col0 + (j & 1) * 64 + (j >> 1) * hstep + n8;
            a[j] = *(const float4*)sp; b[j] = *(const float4*)(sp + 4);
        }
#pragma unroll
        for (int j = 0; j < 4; ++j) {
            float* t = tile + j * (64 * 65) + k * 65 + n8;
            t[0] = a[j].x; t[1] = a[j].y; t[2] = a[j].z; t[3] = a[j].w; t[4] = b[j].x; t[5] = b[j].y; t[6] = b[j].z; t[7] = b[j].w;
        }
    }
    __syncthreads();
    {
        const int n = tid >> 3, k8 = (tid & 7) * 8;
#pragma unroll
        for (int j = 0; j < 4; ++j) {
            const float* t = tile + j * (64 * 65) + n;
            u32x4 w;
            w.x = pk2(t[(k8 + 0) * 65] * scale, t[(k8 + 1) * 65] * scale); w.y = pk2(t[(k8 + 2) * 65] * scale, t[(k8 + 3) * 65] * scale);
            w.z = pk2(t[(k8 + 4) * 65] * scale, t[(k8 + 5) * 65] * scale); w.w = pk2(t[(k8 + 6) * 65] * scale, t[(k8 + 7) * 65] * scale);
            *(u32x4*)(dst + (size_t)(n0 + j * 64 + n) * ldd + k0 + k8) = w;
        }
    }
    __syncthreads();
}

DI void mod_task(const Params& p, int task, float* sm, const int wv) {
    float* cact = sm;
    float* red = sm + 8 * 1024;
    const int tid = TIDX(wv);
    for (int i = tid; i < 8 * 1024; i += 512) cact[i] = siluf_(p.c[i]);
    __syncthreads();
    const int col = task * 64 + (tid & 63), ks = tid >> 6;
    float acc[8];
#pragma unroll
    for (int b = 0; b < 8; ++b) acc[b] = 0.f;
    for (int k = ks * 128; k < ks * 128 + 128; ++k) {
        const float w = p.w_mod[(size_t)k * 3072 + col];
#pragma unroll
        for (int b = 0; b < 8; ++b) acc[b] += cact[b * 1024 + k] * w;
    }
#pragma unroll
    for (int b = 0; b < 8; ++b) red[(ks * 64 + (tid & 63)) * 8 + b] = acc[b];
    __syncthreads();
    {
        const int cc = tid & 63, b = tid >> 6;
        float s = 0.f;
        for (int k2 = 0; k2 < 8; ++k2) s += red[(k2 * 64 + cc) * 8 + b];
        float* mod = (float*)(p.ws + OFF_MOD);
        mod[b * 3072 + task * 64 + cc] = s + p.b_mod[task * 64 + cc];
    }
    __syncthreads();
}

DI void phase_prologue(const Params& p, float* sm, const int wv) {
    constexpr int T_WIN = 24 * 16, T_WGL = 8 * 16, T_SQ = 4 * 16, T_WGT = 64, T_MOD = 48;
    constexpr int E0 = T_WIN, E1 = E0 + T_WGL, E2 = E1 + T_SQ, E3 = E2 + T_SQ, E4 = E3 + T_SQ, E5 = E4 + T_WGT, E6 = E5 + T_MOD, E7 = E6 + 1;
    for (int t0 = blockIdx.x; t0 < E7; t0 += gridDim.x) {
        const int t = t0 < T_MOD ? E5 + t0 : t0 < E5 + T_MOD ? t0 - T_MOD : t0;
        if (t < E0) {
            const int pn = t >> 4, kt = t & 15, sec = pn >> 2;
            const int wbase = (sec == 0 ? 0 : sec == 1 ? 2048 : sec == 2 ? 3072 : sec == 3 ? 4096 : sec == 4 ? 1024 : 5120) + (pn & 3) * 256;
            transpose_tile4(p.w_in, 8192, wbase, 128, kt * 64, (bf16_t*)(p.ws + OFF_WINT), 1024, pn * 256, sec == 1 ? QSCALE : 1.0f, sm, wv);
        } else if (t < E1) {
            const int u = t - E0, pn = u >> 4, kt = u & 15;
            transpose_tile4(p.w_in, 8192, 6144 + pn * 128, 1024, kt * 64, (bf16_t*)(p.ws + OFF_WGL), 1024, pn * 256, 1.0f, sm, wv);
        } else if (t < E4) {
            const int which = t < E2 ? 0 : t < E3 ? 1 : 2;
            const int u = t - (which == 0 ? E1 : which == 1 ? E2 : E3), pn = u >> 4, kt = u & 15;
            const float* src = which == 0 ? p.w_out_rnn : which == 1 ? p.w_out_attn : p.w_o;
            bf16_t* dst = (bf16_t*)(p.ws + (which == 0 ? OFF_WR : which == 1 ? OFF_WA : OFF_WO));
            transpose_tile4(src, 1024, pn * 256, 128, kt * 64, dst, 1024, pn * 256, 1.0f, sm, wv);
        } else if (t < E5) {
            const int u = t - E4, hb = u >> 3, g = (u >> 2) & 1, nt2 = (u >> 1) & 1, kt = u & 1;
            const float* src = (g ? p.w_x : p.w_a) + hb * 16384;
            bf16_t* dst = (bf16_t*)(p.ws + OFF_WGT) + hb * 256 * 128;
            transpose_tile(src, 128, nt2 * 64, kt * 64, dst, 128, g * 128 + nt2 * 64, sm, wv);
        } else if (t < E6) {
            mod_task(p, t - E5, sm, wv);
            asm volatile("s_waitcnt vmcnt(0)" ::: "memory");
            __syncthreads();
            if (TIDX(wv) == 0) {
                __builtin_amdgcn_fence(__ATOMIC_RELEASE, "agent");
                asm volatile("s_waitcnt vmcnt(0)" ::: "memory");
                __hip_atomic_fetch_add((unsigned*)(p.ws + OFF_BAR) + MOD_CNT_WORD, 1u, __ATOMIC_RELAXED, __HIP_MEMORY_SCOPE_AGENT);
            }
        } else {
            float* sp = (float*)(p.ws + OFF_SP);
            for (int i = TIDX(wv); i < 1024; i += 512) sp[i] = -8.0f * log1pf(__expf(-p.lam[i]));
        }
    }
}

DI void phase_h(const Params& p, const int wv) {
    const int lane = lane_id(), wid = wv;
    const float* mod = (const float*)(p.ws + OFF_MOD);
    float4 gn[4];
#pragma unroll
    for (int i = 0; i < 4; ++i) gn[i] = *(const float4*)(p.g_norm + i * 256 + lane * 4);
    for (int r16 = blockIdx.x; r16 < M / 16; r16 += gridDim.x) {
        const int row0 = r16 * 16 + wid * 2;
        const int b = row0 / SEQ;
        float4 v[2][4]; float ss[2] = {0.f, 0.f};
#pragma unroll
        for (int rr = 0; rr < 2; ++rr)
#pragma unroll
            for (int i = 0; i < 4; ++i) v[rr][i] = *(const float4*)(p.x + (size_t)(row0 + rr) * D + i * 256 + lane * 4);
#pragma unroll
        for (int rr = 0; rr < 2; ++rr) {
#pragma unroll
            for (int i = 0; i < 4; ++i) ss[rr] += v[rr][i].x * v[rr][i].x + v[rr][i].y * v[rr][i].y + v[rr][i].z * v[rr][i].z + v[rr][i].w * v[rr][i].w;
            ss[rr] = wave_sum(ss[rr]);
        }
#pragma unroll
        for (int i = 0; i < 4; ++i) {
            const int c0 = i * 256 + lane * 4;
            const float4 sh = *(const float4*)(mod + b * 3072 + c0);
            const float4 sc = *(const float4*)(mod + b * 3072 + 1024 + c0);
            const float4 g = gn[i];
#pragma unroll
            for (int rr = 0; rr < 2; ++rr) {
                const float rstd = rsqrtf(ss[rr] * (1.0f / D) + 1e-6f);
                u32x2 o;
                o.x = pk2(v[rr][i].x * rstd * g.x * (1.f + sc.x) + sh.x, v[rr][i].y * rstd * g.y * (1.f + sc.y) + sh.y);
                o.y = pk2(v[rr][i].z * rstd * g.z * (1.f + sc.z) + sh.z, v[rr][i].w * rstd * g.w * (1.f + sc.w) + sh.w);
                *(u32x2*)((bf16_t*)(p.ws + OFF_H) + (size_t)(row0 + rr) * D + c0) = o;
            }
        }
        if (lane < 32) {
            const int rr = lane >> 4, f = lane & 15;
            const float ang = (float)p.pos[row0 + rr] * p.inv_freq[f];
            float s, c; sincosf(ang, &s, &c);
            float2* tab = (float2*)(p.ws + OFF_ROPE);
            tab[(size_t)(row0 + rr) * 16 + f] = make_float2(c, s);
        }
    }
}

typedef float f32x16 __attribute__((ext_vector_type(16)));
DI int crow(int r, int hi) { return (r & 3) + 8 * (r >> 2) + 4 * hi; }
constexpr int RS = 272;
constexpr int R_WG = 0, R_XC = 256 * RS, R_Z = R_XC + 128 * RS, R_SUMS = R_Z + 32768, R_CAR = R_SUMS + 4096;

template <bool PASS2> DI void phase_rnn(const Params& p, unsigned char* lds, const int wv) {
    LAS unsigned char* l3 = (LAS unsigned char*)lds;
    int tid = TIDX(wv); asm volatile("" : "+v"(tid));
    const int lane = tid & 63, wid = wv, wt = wid & 3, wch = wid >> 2, l31 = lane & 31, h2 = lane >> 5;
    bf16_t* PX = (bf16_t*)(p.ws + OFF_PX);
    float* SUMA = (float*)(p.ws + OFF_SUM); float* SUMB = SUMA + 8 * 64 * 1024;
    const float* sp = (const float*)(p.ws + OFF_SP);
    LAS float* SUMS = (LAS float*)(l3 + R_SUMS);
    LAS float* CAR = (LAS float*)(l3 + R_CAR);
    for (int strip = blockIdx.x; strip < 256; strip += gridDim.x) {
        const int hb = strip & 7, jj = strip >> 3, b = jj >> 2, ck0 = (jj & 3) * 16;
        __syncthreads();
        {
            const bf16_t* wg = (const bf16_t*)(p.ws + OFF_WGT) + hb * 256 * 128;
            const unsigned woff = (unsigned)(((tid >> 4) * 128 + (tid & 15) * 8) * 2), wlds = (unsigned)(R_WG + (tid >> 4) * RS + (tid & 15) * 16);
#pragma unroll
            for (int i = 0; i < 8; ++i) {
                const u32x4 v = *(const u32x4*)((const char*)wg + woff + i * 8192u);
                *(LAS u32x4*)(l3 + wlds + i * (32 * RS)) = v;
            }
        }
        unsigned bxc[2], bzz[2];
#pragma unroll
        for (int nt = 0; nt < 2; ++nt) {
            bxc[nt] = R_XC + (wt * 32 + 4 * h2) * RS + (wch * 64 + nt * 32 + l31) * 2;
            bzz[nt] = R_Z + (wt * 32 + 4 * h2) * 256 + (wch * 64 + nt * 32 + l31) * 2;
        }
        float ba[2], bxv[2], spl[2];
#pragma unroll
        for (int nt = 0; nt < 2; ++nt) { const int ch = hb * 128 + wch * 64 + nt * 32 + l31; ba[nt] = p.b_a[ch]; bxv[nt] = p.b_x[ch]; spl[nt] = sp[ch] * 1.4426950408889634f; }
        if (PASS2) {
            if (tid < 128) {
                const int ch = hb * 128 + tid; float h = 0.f;
                for (int cc = 0; cc < ck0; ++cc) { const size_t o = (size_t)(b * 64 + cc) * 1024 + ch; h = SUMA[o] * h + SUMB[o]; }
                CAR[tid] = h;
            }
        }
        u32x4 xr[7], zr[4]; int posv = 1;
        const unsigned xoff = (unsigned)(((tid >> 4) * 4 * 128 + (tid & 15) * 8) * 2);
        const unsigned zoff = (unsigned)(((tid >> 4) * 128 + (tid & 15) * 8) * 2) + (unsigned)(PXS_ZR * 2);
        auto load_tile = [&](int tokb, int tt0) {
            asm volatile("" : "+s"(tokb));
            const char* tb = (const char*)(PX + PXS_XR + ((size_t)tokb + (size_t)(b * 7 + hb) * SEQ) * 128);
            const int tq = tid >> 4;
#pragma unroll
            for (int i = 0; i < 7; ++i) {
                if (tt0 + tq * 4 + i - 3 >= 0) xr[i] = *(const u32x4*)(tb + (ptrdiff_t)(i - 3) * 256 + xoff);
                else xr[i] = (u32x4){0u, 0u, 0u, 0u};
            }
            if (PASS2) {
#pragma unroll
                for (int i = 0; i < 4; ++i) zr[i] = *(const u32x4*)(tb + (size_t)i * (32 * 256) + zoff);
            }
            posv = p.pos[tokb + wt * 32 + l31];
        };
        load_tile(b * SEQ + ck0 * 128, ck0 * 128);
        for (int ci = 0; ci < 16; ++ci) {
            const int ck = ck0 + ci, t0 = ck * 128, tokbase = b * SEQ + t0;
            {
                const int ch8 = tid & 15, tq = tid >> 4;
                const float* cwp = p.conv_w + hb * 128 + ch8 * 8;
                f32x4 cw[4][2], cb[2];
#pragma unroll
                for (int k = 0; k < 4; ++k) { cw[k][0] = *(const f32x4*)(cwp + k * 1024); cw[k][1] = *(const f32x4*)(cwp + k * 1024 + 4); }
                cb[0] = *(const f32x4*)(p.conv_b + hb * 128 + ch8 * 8); cb[1] = *(const f32x4*)(p.conv_b + hb * 128 + ch8 * 8 + 4);
#pragma unroll
                for (int o = 0; o < 4; ++o) {
                    float y[8];
#pragma unroll
                    for (int e = 0; e < 8; ++e) y[e] = cb[e >> 2][e & 3];
#pragma unroll
                    for (int k = 0; k < 4; ++k) {
                        const u32x4 xv = xr[o + k];
#pragma unroll
                        for (int e2 = 0; e2 < 4; ++e2) {
                            const unsigned w = xv[e2];
                            y[2 * e2] += cw[k][(2 * e2) >> 2][(2 * e2) & 3] * __uint_as_float(w << 16);
                            y[2 * e2 + 1] += cw[k][(2 * e2 + 1) >> 2][(2 * e2 + 1) & 3] * __uint_as_float(w & 0xffff0000u);
                        }
                    }
                    const int tt = tq * 4 + o;
                    u32x4 w; w.x = pk2(y[0], y[1]); w.y = pk2(y[2], y[3]); w.z = pk2(y[4], y[5]); w.w = pk2(y[6], y[7]);
                    *(LAS u32x4*)(l3 + R_XC + tt * RS + ch8 * 16) = w;
                }
            }
            const unsigned rbh = ((unsigned)__ballot(posv == 0)) >> (4 * h2);
            if (PASS2) {
#pragma unroll
                for (int i = 0; i < 4; ++i) *(LAS u32x4*)(l3 + R_Z + (i * 32 + (tid >> 4)) * 256 + (tid & 15) * 16) = zr[i];
            }
            if (ci + 1 < 16) load_tile(tokbase + 128, t0 + 128);
            __syncthreads();
            f32x16 accA[2], accX[2];
#pragma unroll
            for (int nt = 0; nt < 2; ++nt)
#pragma unroll
                for (int r = 0; r < 16; ++r) { accA[nt][r] = 0.f; accX[nt][r] = 0.f; }
            {
                const unsigned abase = R_XC + (wt * 32 + l31) * RS + h2 * 16;
                const unsigned bbase = R_WG + (wch * 64 + l31) * RS + h2 * 16;
#pragma unroll
                for (int ks = 0; ks < 8; ++ks) {
                    const unsigned kb = (unsigned)(ks * 32);
                    const bf16x8 af = *(const LAS bf16x8*)(l3 + abase + kb);
#pragma unroll
                    for (int nt = 0; nt < 2; ++nt) {
                        const bf16x8 bA = *(const LAS bf16x8*)(l3 + bbase + nt * 32 * RS + kb);
                        const bf16x8 bX = *(const LAS bf16x8*)(l3 + bbase + (128 + nt * 32) * RS + kb);
                        accA[nt] = __builtin_amdgcn_mfma_f32_32x32x16_bf16(af, bA, accA[nt], 0, 0, 0);
                        accX[nt] = __builtin_amdgcn_mfma_f32_32x32x16_bf16(af, bX, accX[nt], 0, 0, 0);
                    }
                }
            }
#pragma unroll
            for (int nt = 0; nt < 2; ++nt)
#pragma unroll
                for (int r = 0; r < 16; ++r) {
                    const float xcv = bf2f(*(const LAS bf16_t*)(l3 + bxc[nt] + ((r & 3) + 8 * (r >> 2)) * RS));
                    const float rr = fsig(accA[nt][r] + ba[nt]), ii = fsig(accX[nt][r] + bxv[nt]);
                    float a = __builtin_amdgcn_exp2f(spl[nt] * rr);
                    float mult = __builtin_amdgcn_sqrtf(fmaxf(1.0f - a * a, 0.f));
                    const bool rst = (rbh >> ((r & 3) + 8 * (r >> 2))) & 1u;
                    a = rst ? 0.f : a; mult = rst ? 1.f : mult;
                    accA[nt][r] = a; accX[nt][r] = mult * ii * xcv;
                }
            float loA[2][4], loB[2][4], hiA[2][4], hiB[2][4];
#pragma unroll
            for (int nt = 0; nt < 2; ++nt)
#pragma unroll
                for (int s4 = 0; s4 < 4; ++s4) {
                    float A = 1.f, B = 0.f;
#pragma unroll
                    for (int r4 = 0; r4 < 4; ++r4) { const float a = accA[nt][4 * s4 + r4]; B = a * B + accX[nt][4 * s4 + r4]; A *= a; }
                    const float pA = __shfl_xor(A, 32), pB = __shfl_xor(B, 32);
                    loA[nt][s4] = h2 ? pA : A; loB[nt][s4] = h2 ? pB : B; hiA[nt][s4] = h2 ? A : pA; hiB[nt][s4] = h2 ? B : pB;
                }
#pragma unroll
            for (int nt = 0; nt < 2; ++nt) {
                float At = 1.f, Bt = 0.f;
#pragma unroll
                for (int s4 = 0; s4 < 4; ++s4) { Bt = loA[nt][s4] * Bt + loB[nt][s4]; At *= loA[nt][s4]; Bt = hiA[nt][s4] * Bt + hiB[nt][s4]; At *= hiA[nt][s4]; }
                if (h2 == 0) { const int cl = wch * 64 + nt * 32 + l31; SUMS[(wt * 128 + cl) * 2] = At; SUMS[(wt * 128 + cl) * 2 + 1] = Bt; }
            }
            __syncthreads();
            if (!PASS2) {
                if (tid < 128) {
                    float A = 1.f, B = 0.f;
#pragma unroll
                    for (int w = 0; w < 4; ++w) { const float a = SUMS[(w * 128 + tid) * 2], bb = SUMS[(w * 128 + tid) * 2 + 1]; B = a * B + bb; A *= a; }
                    const size_t o = (size_t)(b * 64 + ck) * 1024 + hb * 128 + tid;
                    SUMA[o] = A; SUMB[o] = B;
                }
                __syncthreads();
            } else {
#pragma unroll
                for (int nt = 0; nt < 2; ++nt) {
                    const int cl = wch * 64 + nt * 32 + l31;
                    float H = CAR[cl];
                    for (int w = 0; w < wt; ++w) H = SUMS[(w * 128 + cl) * 2] * H + SUMS[(w * 128 + cl) * 2 + 1];
#pragma unroll
                    for (int s4 = 0; s4 < 4; ++s4) {
                        const float Hlo = loA[nt][s4] * H + loB[nt][s4];
                        float Hs = h2 ? Hlo : H;
                        H = hiA[nt][s4] * Hlo + hiB[nt][s4];
#pragma unroll
                        for (int r4 = 0; r4 < 4; ++r4) {
                            const int r = 4 * s4 + r4;
                            Hs = accA[nt][r] * Hs + accX[nt][r];
                            const float z = bf2f(*(const LAS bf16_t*)(l3 + bzz[nt] + ((r & 3) + 8 * (r >> 2)) * 256));
                            *(LAS bf16_t*)(l3 + bxc[nt] + ((r & 3) + 8 * (r >> 2)) * RS) = f2bf(Hs * z * fsig(z));
                        }
                    }
                }
                __syncthreads();
#pragma unroll
                for (int i = 0; i < 4; ++i) {
                    const int tt = i * 32 + (tid >> 4), c16 = tid & 15;
                    const u32x4 v = *(const LAS u32x4*)(l3 + R_XC + tt * RS + c16 * 16);
                    *(u32x4*)(PX + PXS_ZR + hmrow(b, hb, (size_t)(t0 + tt)) + c16 * 8) = v;
                }
                if (tid < 128) {
                    float H = CAR[tid];
#pragma unroll
                    for (int w = 0; w < 4; ++w) H = SUMS[(w * 128 + tid) * 2] * H + SUMS[(w * 128 + tid) * 2 + 1];
                    CAR[tid] = H;
                }
                __syncthreads();
            }
        }
    }
}


typedef short s16x4 __attribute__((ext_vector_type(4)));
DI unsigned off_b(unsigned row, unsigned ch) { return 256u * row + 16u * (ch ^ (((row & 3u) << 2) | ((row >> 2) & 3u))); }
constexpr int AT_KV = 0, AT_LS = 98304, AT_STG = 100352, STG_RS = 144;

template <int MODE> DI void phase_attn(const Params& p, unsigned char* lds, const int wv) {
    LAS unsigned char* l3 = (LAS unsigned char*)lds;
    int tid = TIDX(wv); asm volatile("" : "+v"(tid));
    const int lane = tid & 63, w = wv, l31 = lane & 31, h2 = lane >> 5;
    bf16_t* PX = (bf16_t*)(p.ws + OFF_PX);
    const bf16_t* QH = (const bf16_t*)(p.ws + OFF_QH);
    constexpr size_t SEC_K = (size_t)M * 1024, SEC_V = (size_t)2 * M * 1024;
    bf16_t* O3 = (bf16_t*)p.out; bf16_t* O2 = O3 + (size_t)M * 1024;
    float* LSE3 = (float*)(p.ws + OFF_LSE); float* LSE2 = LSE3 + (size_t)M * 8;
    LAS float* wls = (LAS float*)(l3 + AT_LS) + w * 32;
    const unsigned stg = AT_STG + w * (32 * STG_RS);
    constexpr int NII = (MODE == 0) ? 2 : 1;
    const int total = 64 * 32 * NII;
    const int kk = tid >> 4, c16 = tid & 15;
    const float NEG = -__builtin_inff();
    u32x4 pre[12];
    bf16x8 qf[8];
    int L = blockIdx.x;
    auto decode = [&](int L_, int& b, int& h, int& dil, int& r, int& blk) {
        const int xcd = L_ & 7, idx = (L_ >> 3) & 31, rnd = L_ >> 8;
        const int bh = xcd + 8 * (rnd / NII), ii = rnd % NII;
        b = bh >> 3; h = bh & 7;
        const int set = idx & 1, s16 = idx >> 1;
        if (MODE == 1) { dil = 1; r = 0; blk = set * 16 + s16; }
        else if (s16 < 8) { dil = 16; r = 4 * (s16 >> 1) + 2 * set + (s16 & 1); blk = ii; }
        else { dil = 4; r = 2 * set + (s16 & 1); blk = ii * 4 + ((s16 - 8) >> 1); }
    };
    auto prefetch = [&](size_t sec, int b, int h, int dil, int r, int blk) {
        const char* ub = (const char*)(QH + sec + ((ptrdiff_t)(b * 8 + h) * SEQ + (ptrdiff_t)(blk * 256 - 128) * dil + r) * 128);
        unsigned lo = (unsigned)((kk * dil * 128 + c16 * 8) * 2);
        asm volatile("" : "+v"(lo));
        const ptrdiff_t tstep = (ptrdiff_t)32 * dil * 256;
#pragma unroll
        for (int i = 0; i < 12; ++i) {
            if (blk > 0 || i >= 4) pre[i] = *(const u32x4*)(ub + (ptrdiff_t)i * tstep + lo);
        }
    };
    auto stash = [&]() {
#pragma unroll
        for (int i = 0; i < 12; ++i) *(LAS u32x4*)(l3 + AT_KV + i * 8192 + off_b(kk, c16)) = pre[i];
    };
    auto loadq = [&](bf16x8 (&q)[8], int b, int h, int dil, int r, int blk) {
        const char* ub = (const char*)(QH + ((size_t)(b * 8 + h) * SEQ + (size_t)(blk * 256 + w * 32) * dil + r) * 128);
        unsigned lo = (unsigned)((l31 * dil * 128 + h2 * 8) * 2);
        asm volatile("" : "+v"(lo));
#pragma unroll
        for (int ks = 0; ks < 8; ++ks) q[ks] = *(const bf16x8*)(ub + lo + ks * 32);
    };
    unsigned kbase[8];
    { const unsigned xk = ((l31 & 3u) << 2) | ((l31 >> 2) & 3u);
#pragma unroll
      for (int ks = 0; ks < 8; ++ks) kbase[ks] = AT_KV + 256u * l31 + 16u * ((unsigned)(2 * ks + h2) ^ xk); }
    unsigned vbase[4][2];
    { const unsigned blkk = (lane >> 4) & 1u, q4 = (lane & 15u) >> 2, pp = lane & 3u;
#pragma unroll
      for (int d = 0; d < 4; ++d)
#pragma unroll
        for (int t = 0; t < 2; ++t) {
            const unsigned row = 8u * t + 4u * h2 + q4, ch = 4u * d + 2u * blkk + (pp >> 1);
            vbase[d][t] = AT_KV + 256u * row + 16u * (ch ^ ((q4 << 2) | ((2u * t + h2) & 3u))) + 8u * (pp & 1u);
        } }
    if (L < total) { int b, h, dil, r, blk; decode(L, b, h, dil, r, blk); prefetch(SEC_K, b, h, dil, r, blk); loadq(qf, b, h, dil, r, blk); }
    for (; L < total; L += gridDim.x) {
        int b, h, dil, r, blk; decode(L, b, h, dil, r, blk);
        stash();
        __syncthreads();
        prefetch(SEC_V, b, h, dil, r, blk);
        float m = -1e30f, lh = 0.f, alpha[5];
        bf16x8 pf[5][2];
        f32x16 Sa, Sb;
#define AT_QK(J, SV) do { \
            _Pragma("unroll") for (int rr = 0; rr < 16; ++rr) SV[rr] = 0.f; \
            bf16x8 kf[8]; \
            _Pragma("unroll") for (int ks = 0; ks < 8; ++ks) kf[ks] = *(const LAS bf16x8*)(l3 + kbase[ks] + (w + (J)) * 8192); \
            __builtin_amdgcn_sched_barrier(0); \
            _Pragma("unroll") for (int ks = 0; ks < 8; ++ks) SV = __builtin_amdgcn_mfma_f32_32x32x16_bf16(kf[ks], qf[ks], SV, 0, 0, 0); \
        } while (0)
#define AT_SMX(J, SV) do { \
            if (blk == 0 && w + (J) < 4) { _Pragma("unroll") for (int rr = 0; rr < 16; ++rr) SV[rr] = NEG; }        \
            if ((J) == 0) { _Pragma("unroll") for (int rr = 0; rr < 16; ++rr) if (crow(rr, h2) < l31) SV[rr] = NEG; }     \
            if ((J) == 4) { _Pragma("unroll") for (int rr = 0; rr < 16; ++rr) if (crow(rr, h2) > l31) SV[rr] = NEG; }     \
            float tm = SV[0]; \
            _Pragma("unroll") for (int rr = 1; rr < 16; ++rr) tm = fmaxf(tm, SV[rr]); \
            tm = fmaxf(tm, __shfl_xor(tm, 32)); \
            const float mn = fmaxf(m, tm); \
            alpha[J] = __builtin_amdgcn_exp2f(m - mn); m = mn; \
            float ps = 0.f; \
            _Pragma("unroll") for (int rr = 0; rr < 16; ++rr) { SV[rr] = __builtin_amdgcn_exp2f(SV[rr] - mn); ps += SV[rr]; } \
            lh = lh * alpha[J] + ps; \
            _Pragma("unroll") for (int s = 0; s < 2; ++s) { \
                u32x4 wv; wv.x = pk2(SV[8 * s + 0], SV[8 * s + 1]); wv.y = pk2(SV[8 * s + 2], SV[8 * s + 3]); \
                wv.z = pk2(SV[8 * s + 4], SV[8 * s + 5]); wv.w = pk2(SV[8 * s + 6], SV[8 * s + 7]); \
                pf[J][s] = __builtin_bit_cast(bf16x8, wv); } \
        } while (0)
        AT_QK(0, Sa);
        AT_QK(1, Sb); AT_SMX(0, Sa);
        AT_QK(2, Sa); AT_SMX(1, Sb);
        AT_QK(3, Sb); AT_SMX(2, Sa);
        AT_QK(4, Sa); AT_SMX(3, Sb);
        AT_SMX(4, Sa);
#undef AT_QK
#undef AT_SMX
        const float lt = lh + __shfl_xor(lh, 32);
        const float linv = __builtin_amdgcn_rcpf(lt);
        if (h2 == 0) wls[l31] = m + __builtin_amdgcn_logf(lt);
        __syncthreads();
        stash();
        __syncthreads();
        const int Ln = L + gridDim.x;
        if (Ln < total) { int b2, h2_, dil2, r2, blk2; decode(Ln, b2, h2_, dil2, r2, blk2); prefetch(SEC_K, b2, h2_, dil2, r2, blk2); }
#pragma unroll
        for (int hd = 0; hd < 2; ++hd) {
            f32x16 O[2];
#pragma unroll
            for (int dd = 0; dd < 2; ++dd)
#pragma unroll
                for (int rr = 0; rr < 16; ++rr) O[dd][rr] = 0.f;
#pragma unroll
            for (int j = 0; j < 5; ++j) {
                if (!(blk == 0 && w + j < 4)) {
                    if (!__all(alpha[j] == 1.0f)) {
#pragma unroll
                        for (int dd = 0; dd < 2; ++dd)
#pragma unroll
                            for (int rr = 0; rr < 16; ++rr) O[dd][rr] *= alpha[j];
                    }
                    s16x4 tv[2][2][2];
#pragma unroll
                    for (int s = 0; s < 2; ++s)
#pragma unroll
                        for (int dd = 0; dd < 2; ++dd)
#pragma unroll
                            for (int t = 0; t < 2; ++t)
                                tv[s][dd][t] = __builtin_amdgcn_ds_read_tr16_b64_v4i16((LAS s16x4*)(l3 + vbase[hd * 2 + dd][t] + (w + j) * 8192 + s * 4096));
                    __builtin_amdgcn_sched_barrier(0);
                    __builtin_amdgcn_s_setprio(1);
#pragma unroll
                    for (int s = 0; s < 2; ++s)
#pragma unroll
                        for (int dd = 0; dd < 2; ++dd) {
                            const bf16x8 vf = __builtin_shufflevector(tv[s][dd][0], tv[s][dd][1], 0, 1, 2, 3, 4, 5, 6, 7);
                            O[dd] = __builtin_amdgcn_mfma_f32_32x32x16_bf16(vf, pf[j][s], O[dd], 0, 0, 0);
                        }
                    __builtin_amdgcn_s_setprio(0);
                    __builtin_amdgcn_sched_barrier(0);
                }
            }
#pragma unroll
            for (int dd = 0; dd < 2; ++dd)
#pragma unroll
                for (int g = 0; g < 4; ++g) {
                    u32x2 wv; wv.x = pk2(O[dd][4 * g] * linv, O[dd][4 * g + 1] * linv); wv.y = pk2(O[dd][4 * g + 2] * linv, O[dd][4 * g + 3] * linv);
                    *(LAS u32x2*)(l3 + stg + l31 * STG_RS + (dd * 32 + 8 * g + 4 * h2) * 2) = wv;
                }
            if (hd == 1) {
                __builtin_amdgcn_sched_barrier(0);
                if (Ln < total) { int b2, h2_, dil2, r2, blk2; decode(Ln, b2, h2_, dil2, r2, blk2); loadq(qf, b2, h2_, dil2, r2, blk2); }
                __builtin_amdgcn_sched_barrier(0);
            }
#pragma unroll
            for (int it = 0; it < 4; ++it) {
                const int q = it * 8 + (lane >> 3), cc = lane & 7;
                const u32x4 o1 = *(const LAS u32x4*)(l3 + stg + q * STG_RS + cc * 16);
                const size_t sq = (size_t)(blk * 256 + w * 32 + q) * dil + r, tok = (size_t)b * SEQ + sq;
                const int col = h * 128 + hd * 64 + cc * 8;
                if (MODE == 0) {
                    bf16_t* Ob = (dil == 16) ? O3 : O2;
                    *(u32x4*)(Ob + hmrow(b, h, sq) + hd * 64 + cc * 8) = o1;
                } else {
                    const u32x4 o2 = *(const u32x4*)(O2 + hmrow(b, h, sq) + hd * 64 + cc * 8);
                    const u32x4 o3 = *(const u32x4*)(O3 + hmrow(b, h, sq) + hd * 64 + cc * 8);
                    bf16_t* zp = PX + PXS_ZA + hmrow(b, h, sq) + hd * 64 + cc * 8;
                    const u32x4 zv = *(const u32x4*)zp;
                    const float e1 = wls[q], e2 = LSE2[(size_t)(b * 8 + h) * SEQ + sq], e3 = LSE3[(size_t)(b * 8 + h) * SEQ + sq];
                    const float em = fmaxf(e1, fmaxf(e2, e3));
                    float w1 = __builtin_amdgcn_exp2f(e1 - em), w2 = __builtin_amdgcn_exp2f(e2 - em), w3 = __builtin_amdgcn_exp2f(e3 - em);
                    const float wn = __builtin_amdgcn_rcpf(w1 + w2 + w3); w1 *= wn; w2 *= wn; w3 *= wn;
                    u32x4 res;
#pragma unroll
                    for (int e = 0; e < 4; ++e) {
                        const float a0 = w1 * bflo(o1[e]) + w2 * bflo(o2[e]) + w3 * bflo(o3[e]);
                        const float a1 = w1 * bfhi(o1[e]) + w2 * bfhi(o2[e]) + w3 * bfhi(o3[e]);
                        const float z0 = bflo(zv[e]), z1 = bfhi(zv[e]);
                        res[e] = pk2(a0 * z0 * fsig(z0), a1 * z1 * fsig(z1));
                    }
                    *(u32x4*)zp = res;
                }
            }
        }
        if (MODE == 0) {
            if (h2 == 0) {
                const size_t sq = (size_t)(blk * 256 + w * 32 + l31) * dil + r;
                float* Lb = (dil == 16) ? LSE3 : LSE2;
                Lb[(size_t)(b * 8 + h) * SEQ + sq] = m + __builtin_amdgcn_logf(lt);
            }
        }
        __syncthreads();
    }
}

#define XB_TMO      128
#define XB_XCNT(j)  (256  + 64 * (j))
#define XB_XSUB(j)  (1280 + 64 * (j))
#define XB_XGEN(j)  (2304 + 64 * (j))
#define XB_TOP      3328
#define XB_TOPGEN   3392
#define XCD_BAR_WORDS 3456
#define XB_SPIN_CAP (1u << 22)
DI unsigned xb_ld(unsigned* p)              { return __hip_atomic_load(p, __ATOMIC_RELAXED, __HIP_MEMORY_SCOPE_AGENT); }
DI unsigned xb_add(unsigned* p, unsigned v) { return __hip_atomic_fetch_add(p, v, __ATOMIC_RELAXED, __HIP_MEMORY_SCOPE_AGENT); }
DI unsigned xb_xcc_id() { return (unsigned)__builtin_amdgcn_s_getreg((3 << 11) | 20) & 0xFu; }
#define XB_SPIN(cond, bar) do { unsigned _sp = 0; while (cond) { __builtin_amdgcn_s_sleep(1); \
    if ((++_sp & 255u) == 0u) { if (xb_ld(&(bar)[XB_TMO])) break; if (_sp > XB_SPIN_CAP) { atomicAdd(&(bar)[XB_TMO], 1u); break; } } } } while (0)
struct XcdBarrier { unsigned* bar; unsigned x; volatile LAS unsigned* st; int wv; };
DI XcdBarrier xcd_barrier_post(unsigned* bar, volatile LAS unsigned* st, const int wv) {
    XcdBarrier b; b.bar = bar; b.x = xb_xcc_id(); b.st = st; b.wv = wv;
    if (TIDX(wv) == 0) (void)xb_add(&bar[XB_XCNT(b.x)], 1u);
    return b;
}
DI void xcd_barrier_complete(unsigned* bar, unsigned x, unsigned& nloc, unsigned& nx) {
    const unsigned G = gridDim.x * gridDim.y * gridDim.z;
    unsigned sum, cnt, mine, sp = 0u;
    for (;;) {
        sum = 0u; cnt = 0u; mine = 0u;
#pragma unroll
        for (unsigned j = 0; j < 16; ++j) { const unsigned c = xb_ld(&bar[XB_XCNT(j)]); sum += c; cnt += (c > 0u) ? 1u : 0u; mine = (j == x) ? c : mine; }
        if (sum == G) break;
        __builtin_amdgcn_s_sleep(1);
        if ((++sp & 255u) == 0u) { if (xb_ld(&bar[XB_TMO])) break; if (sp > XB_SPIN_CAP) { atomicAdd(&bar[XB_TMO], 1u); break; } }
    }
    nloc = mine > 0u ? mine : 1u; nx = cnt > 0u ? cnt : 1u;
}
DI void xcd_barrier(const XcdBarrier& b) {
    asm volatile("s_waitcnt vmcnt(0)" ::: "memory");
    __syncthreads();
    if (TIDX(b.wv) == 0) {
        unsigned* bar = b.bar;
        __builtin_amdgcn_s_waitcnt(0);
        unsigned nloc = b.st[0], nx = b.st[1];
        if (nloc == 0u) { xcd_barrier_complete(bar, b.x, nloc, nx); b.st[0] = nloc; b.st[1] = nx; }
        const unsigned old = xb_add(&bar[XB_XSUB(b.x)], 1u);
        const unsigned gen = old / nloc;
        if (old + 1u == (gen + 1u) * nloc) {
            __builtin_amdgcn_fence(__ATOMIC_RELEASE, "agent");
            asm volatile("s_waitcnt vmcnt(0)" ::: "memory");
            const unsigned og = xb_add(&bar[XB_TOP], 1u);
            const unsigned tg = og / nx;
            if (og + 1u == (tg + 1u) * nx) xb_add(&bar[XB_TOPGEN], 1u);
            else XB_SPIN(xb_ld(&bar[XB_TOPGEN]) == tg, bar);
            __builtin_amdgcn_fence(__ATOMIC_ACQUIRE, "agent");
            xb_add(&bar[XB_XGEN(b.x)], 1u);
            asm volatile("s_waitcnt vmcnt(0)" ::: "memory");
        } else {
            XB_SPIN(xb_ld(&bar[XB_XGEN(b.x)]) == gen, bar);
            __builtin_amdgcn_fence(__ATOMIC_ACQUIRE, "agent");
            asm volatile("s_waitcnt vmcnt(0)" ::: "memory");
        }
    }
    __syncthreads();
}

constexpr int N_PHASES = 8;
__global__ void __launch_bounds__(512) mega(Params p) {
    extern __shared__ __attribute__((aligned(16))) unsigned char lds[];
    LAS unsigned char* l3 = (LAS unsigned char*)lds;
    float* smf = (float*)lds;
    const int G = gridDim.x, c = blockIdx.x;
    bf16_t* PX = (bf16_t*)(p.ws + OFF_PX); bf16_t* QH = (bf16_t*)(p.ws + OFF_QH); bf16_t* KH = (bf16_t*)(p.ws + OFF_KH);
    const int lo = p.ph_lo, hi = p.ph_hi;
    volatile LAS unsigned* xst = (volatile LAS unsigned*)(l3 + LDS_BYTES - 16);
    const int wv = __builtin_amdgcn_readfirstlane((int)threadIdx.x >> 6);
    if (TIDX(wv) == 0) { xst[0] = 0u; xst[1] = 0u; }
    __syncthreads();
    XcdBarrier xbar = xcd_barrier_post((unsigned*)(p.ws + OFF_BAR), xst, wv);
#define IN(k) (lo <= (k) && (k) < hi)
#define SYNC(k) do { if (IN(k) && IN((k) + 1)) xcd_barrier(xbar); } while (0)
    if (IN(0)) phase_prologue(p, smf, wv);
    if (IN(0) && IN(1)) {
        __syncthreads();
        if (TIDX(wv) == 0) {
            unsigned* mc = (unsigned*)(p.ws + OFF_BAR) + MOD_CNT_WORD; unsigned spins = 0;
            while (__hip_atomic_load(mc, __ATOMIC_RELAXED, __HIP_MEMORY_SCOPE_AGENT) < 48u) { __builtin_amdgcn_s_sleep(2); if (++spins > (1u << 24)) break; }
            __builtin_amdgcn_fence(__ATOMIC_ACQUIRE, "agent");
            asm volatile("s_waitcnt vmcnt(0)" ::: "memory");
        }
        __syncthreads();
    }
    if (IN(1)) phase_h(p, wv);
    SYNC(1);
    if (IN(2)) {
        pg8::TileSched S; S.init(M, NP, G, c, 1, p.ws + OFF_H, nullptr, (size_t)256 * D * 2, 0, p.ws + OFF_WINT, nullptr, 1024);
        EpiProj E{PX, QH, (const float*)(p.ws + OFF_ROPE), l3 + 131072, -1};
        pg8::gemm_phase<EpiProj, pg8::TileSched, true, true>(l3, D, 1024, 16, S, E, wv, 128, 256);
    }
    SYNC(2);
    if (IN(3)) { if ((blockIdx.x >> 3) & 1) { phase_attn<0>(p, lds, wv); phase_rnn<false>(p, lds, wv); } else { phase_rnn<false>(p, lds, wv); phase_attn<0>(p, lds, wv); } }
    SYNC(3);
    if (IN(4)) { if ((blockIdx.x >> 3) & 1) { phase_attn<1>(p, lds, wv); phase_rnn<true>(p, lds, wv); } else { phase_rnn<true>(p, lds, wv); phase_attn<1>(p, lds, wv); } }
    SYNC(4);
    if (IN(5)) {
        pg8::TileSched S; S.init(M, 2048, G, c, 1, p.ws + OFF_H, nullptr, (size_t)256 * D * 2, 0, p.ws + OFF_WGL, nullptr, 1024);
        EpiGate E{KH, p.b_gate};
        pg8::gemm_phase<EpiGate, pg8::TileSched, true, true>(l3, D, 1024, 16, S, E, wv, 128, 256);
    }
    SYNC(5);
    if (IN(6)) {
        pg8::TileSched S; S.init(M, 1024, G, c, 2, PX + PXS_ZR, PX + PXS_ZA, 0, 1, p.ws + OFF_WR, p.ws + OFF_WA, 1024);
        EpiMerged E{QH};
        pg8::gemm_phase<EpiMerged, pg8::TileSched, true, true>(l3, 128, 1024, 16, S, E, wv, 128, (size_t)SEQ * 256);
    }
    SYNC(6);
    if (IN(7)) {
        pg8::TileSched S; S.init(M, 1024, G, c, 1, QH, nullptr, (size_t)256 * 1024 * 2, 0, p.ws + OFF_WO, nullptr, 1024);
        EpiOut E{p.x, (const float*)(p.ws + OFF_MOD), p.g_final, p.out, (float*)(p.ws + OFF_ROWSQ), (unsigned*)(p.ws + OFF_BAR + 16384), l3 + 131072};
        pg8::gemm_phase<EpiOut, pg8::TileSched, true, true>(l3, 64, 1024, 16, S, E, wv, 32768, 65536);
    }
#undef IN
#undef SYNC
}

extern "C" void kernel_launch(void* const* d_in, const int* in_sizes, int n_in, void* d_out, int out_size, void* d_ws, size_t ws_size,
                              hipStream_t stream) {
    static int grid_blocks = 0;
    if (grid_blocks == 0) {
        if (ws_size < OFF_END) { fprintf(stderr, "workspace too small: %zu < %zu\n", ws_size, (size_t)OFF_END); grid_blocks = -1; return; }
        int dev = 0, cus = 0, per_cu = 0;
        (void)hipGetDevice(&dev);
        (void)hipDeviceGetAttribute(&cus, hipDeviceAttributeMultiprocessorCount, dev);
        (void)hipFuncSetAttribute((const void*)mega, hipFuncAttributeMaxDynamicSharedMemorySize, LDS_BYTES);
        (void)hipOccupancyMaxActiveBlocksPerMultiprocessor(&per_cu, (const void*)mega, 512, LDS_BYTES);
        if (per_cu < 1) { fprintf(stderr, "occupancy query says %d blocks per CU\n", per_cu); per_cu = 1; }
        grid_blocks = cus;
        fprintf(stderr, "mega: cus %d per_cu %d grid %d\n", cus, per_cu, grid_blocks);
    }
    if (grid_blocks < 0) return;
    Params p{};
    p.x = (const float*)d_in[0]; p.c = (const float*)d_in[1]; p.pos = (const int*)d_in[2]; p.g_norm = (const float*)d_in[3];
    p.w_mod = (const float*)d_in[4]; p.b_mod = (const float*)d_in[5]; p.w_in = (const float*)d_in[6]; p.b_gate = (const float*)d_in[7];
    p.conv_w = (const float*)d_in[8]; p.conv_b = (const float*)d_in[9]; p.w_a = (const float*)d_in[10]; p.b_a = (const float*)d_in[11];
    p.w_x = (const float*)d_in[12]; p.b_x = (const float*)d_in[13]; p.lam = (const float*)d_in[14]; p.w_out_rnn = (const float*)d_in[15];
    p.w_out_attn = (const float*)d_in[16]; p.w_o = (const float*)d_in[17]; p.g_final = (const float*)d_in[18];
    p.out = (float*)d_out; p.ws = (char*)d_ws;
    for (int i = 0; i < 16; ++i) p.inv_freq[i] = (float)pow(500000.0, -(double)(2 * i) / 32.0);
    p.ph_lo = 0; p.ph_hi = N_PHASES;
    (void)hipMemsetAsync((char*)d_ws + OFF_BAR, 0, BAR_BYTES, stream);
    void* args[] = {&p};
    hipError_t e = hipLaunchCooperativeKernel((const void*)mega, dim3(grid_blocks), dim3(512), args, LDS_BYTES, stream);
    if (e != hipSuccess) fprintf(stderr, "cooperative launch failed: %s (grid %d)\n", hipGetErrorString(e), grid_blocks);
}
```

```cpp
#include <hip/hip_runtime.h>
#include <hip/hip_bf16.h>
#include <hip/hip_cooperative_groups.h>
#include <cstdio>
#include <cstdint>
#include <cmath>
namespace cg = cooperative_groups;

typedef unsigned short bf16_t;
#define DI __device__ __forceinline__
#define LAS __attribute__((address_space(3)))
typedef short bf16x8 __attribute__((ext_vector_type(8)));
typedef float f32x4 __attribute__((ext_vector_type(4)));
typedef unsigned u32x2 __attribute__((ext_vector_type(2)));
typedef unsigned u32x4 __attribute__((ext_vector_type(4)));

constexpr int D = 1024, BATCH = 8, SEQ = 8192, M = BATCH * SEQ;
constexpr int NP = 6144;
constexpr size_t SECN = (size_t)M * 1024;
constexpr size_t PXS_XR = 0, PXS_ZR = SECN, PXS_ZA = 2 * SECN;
DI size_t hmrow(int b, int hb, size_t s) { return ((size_t)(b * 8 + hb) * SEQ + s) * 128; }
constexpr float QSCALE = 0.08838834764831845f * 1.4426950408889634f;
constexpr int LDS_BYTES = 163840;

constexpr size_t OFF_PX = 0;
constexpr size_t OFF_QH = OFF_PX + 3 * (size_t)M * 1024 * 2;
constexpr size_t OFF_KH = OFF_QH + (size_t)M * 1024 * 2;
constexpr size_t OFF_VH = OFF_KH + (size_t)M * 1024 * 2;
constexpr size_t OFF_H = OFF_VH + (size_t)M * 1024 * 2;
constexpr size_t OFF_WINT = OFF_H + (size_t)M * D * 2;
constexpr size_t OFF_WGL = OFF_WINT + (size_t)6144 * 1024 * 2;
constexpr size_t OFF_WR = OFF_WGL + (size_t)2048 * 1024 * 2;
constexpr size_t OFF_WA = OFF_WR + (size_t)1024 * 1024 * 2;
constexpr size_t OFF_WO = OFF_WA + (size_t)1024 * 1024 * 2;
constexpr size_t OFF_WGT = OFF_WO + (size_t)1024 * 1024 * 2;
constexpr size_t OFF_MOD = OFF_WGT + (size_t)8 * 256 * 128 * 2;
constexpr size_t OFF_SP = OFF_MOD + 131072;
constexpr size_t OFF_ROPE = OFF_SP + 4096;
constexpr size_t OFF_SUM = OFF_ROPE + (size_t)M * 16 * 8;
constexpr size_t OFF_LSE = OFF_SUM + (size_t)2 * 8 * 64 * 1024 * 4;
constexpr size_t OFF_ROWSQ = OFF_LSE + (size_t)2 * M * 8 * 4;
constexpr size_t OFF_BAR = OFF_ROWSQ + (size_t)M * 16 * 4;
constexpr size_t BAR_BYTES = 16384 + 65536;
constexpr int MOD_CNT_WORD = 3600;
constexpr size_t OFF_END = OFF_BAR + BAR_BYTES;

struct Params {
    const float* x; const float* c; const int* pos; const float* g_norm; const float* w_mod; const float* b_mod;
    const float* w_in; const float* b_gate; const float* conv_w; const float* conv_b; const float* w_a; const float* b_a;
    const float* w_x; const float* b_x; const float* lam; const float* w_out_rnn; const float* w_out_attn; const float* w_o;
    const float* g_final; float* out; char* ws;
    float inv_freq[16];
    int ph_lo, ph_hi;
};

DI int lane_id() { int r; asm volatile("v_mbcnt_lo_u32_b32 %0, -1, 0\n\tv_mbcnt_hi_u32_b32 %0, -1, %0" : "=v"(r)); return r; }
#define TIDX(wv) ((wv) * 64 + lane_id())
DI float bf2f(bf16_t v) { return __uint_as_float(((unsigned)v) << 16); }
DI bf16_t f2bf(float f) { unsigned u = __float_as_uint(f); u += 0x7fffu + ((u >> 16) & 1u); return (bf16_t)(u >> 16); }
typedef __bf16 bf16x2_t __attribute__((ext_vector_type(2)));
typedef float f32x2_t __attribute__((ext_vector_type(2)));
DI unsigned pk2(float lo, float hi) { const f32x2_t v = {lo, hi}; return __builtin_bit_cast(unsigned, __builtin_convertvector(v, bf16x2_t)); }
DI float bflo(unsigned w) { return __uint_as_float(w << 16); }
DI float bfhi(unsigned w) { return __uint_as_float(w & 0xffff0000u); }
DI float sigmoidf_(float v) { return 1.0f / (1.0f + __expf(-v)); }
DI float siluf_(float v) { return v / (1.0f + __expf(-v)); }
DI float fsig(float v) { return __builtin_amdgcn_rcpf(1.0f + __builtin_amdgcn_exp2f(-1.4426950408889634f * v)); }
typedef unsigned pl_u32x2 __attribute__((ext_vector_type(2)));
DI void half_split(float x, float& lo, float& hi) { const auto r = __builtin_amdgcn_permlane32_swap(__float_as_uint(x), __float_as_uint(x), false, false); lo = __uint_as_float(r[0]); hi = __uint_as_float(r[1]); }
DI float half_max(float x) { float lo, hi; half_split(x, lo, hi); return fmaxf(lo, hi); }
DI float half_sum(float x) { float lo, hi; half_split(x, lo, hi); return lo + hi; }
DI float wave_sum(float v) {
#pragma unroll
    for (int o = 32; o >= 1; o >>= 1) v += __shfl_xor(v, o);
    return v;
}

namespace pg8 {
constexpr int BM = 256, BK = 64, HALF = 128, HTB = HALF * BK * 2, STAGE_BYTES = 8 * HTB, NXCD = 8, WGM = 8;
DI int lds_byte(int r, int c) { const int st = (r >> 4) * 2 + (c >> 5), rr = r & 15, cc = c & 31, ob = rr * 64 + cc * 2; return st * 1024 + (ob ^ (((ob >> 9) & 1) << 5)); }
DI void stage_rc(int b, int& R, int& C) { const int st = b / 1024, sb = b % 1024, swz = sb ^ (((sb >> 9) & 1) << 5); R = (st >> 1) * 16 + swz / 64; C = (st & 1) * 32 + (swz % 64) / 2; }

DI int perm32(int rho) { const int n = rho >> 4, i = rho & 15; return 8 * (i >> 2) + 4 * n + (i & 3); }
struct Unit { int pm, pn, sub; const char* a; const char* b; };

struct TileSched {
    int nM, nN, nwg, G, c, nsub, hmA; const char* A0; const char* A1; const char* B0; const char* B1; size_t tstepA, tstepB;
    DI void init(int M_, int N_, int G_, int c_, int nsub_, const void* a0, const void* a1, size_t tstepA_, int hmA_, const void* b0, const void* b1, int ldb) {
        nM = M_ / BM; nN = N_ / BM; nwg = nM * nN; G = G_; c = c_; nsub = nsub_; hmA = hmA_;
        A0 = (const char*)a0; A1 = (const char*)a1; B0 = (const char*)b0; B1 = (const char*)b1;
        tstepA = tstepA_; tstepB = (size_t)BM * ldb * 2;
    }
    DI bool next(int i, Unit& u) const {
        const int ti = (nsub == 2) ? (i >> 1) : i, sub = (nsub == 2) ? (i & 1) : 0;
        const long L = (long)ti * G + c; if (L >= nwg) return false;
        int wgid = (int)L; { const int q = nwg / NXCD, r = nwg % NXCD, xcd = wgid % NXCD, off = wgid / NXCD; wgid = (xcd < r ? xcd * (q + 1) : r * (q + 1) + (xcd - r) * q) + off; }
        const int nig = WGM * nN, gid = wgid / nig, fm = gid * WGM, gsz = (nM - fm) < WGM ? (nM - fm) : WGM;
        u.pm = fm + ((wgid % nig) % gsz); u.pn = (wgid % nig) / gsz; u.sub = sub;
        u.a = (sub ? A1 : A0) + (hmA ? hmrow(u.pm >> 5, 0, (size_t)(u.pm & 31) * 256) * 2 : (size_t)u.pm * tstepA); u.b = (sub ? B1 : B0) + (size_t)u.pn * tstepB; return true;
    }
};

template <class Epi, class Sched, bool ALIGN_EPI, bool SP2>
DI void gemm_phase(LAS unsigned char* lds, const int lda, const int ldb, const int nt, const Sched& S, const Epi& E, const int wv, const size_t kstepA, const size_t kstep2A) {
    const int wid = wv, lane = lane_id(), tid = wid * 64 + lane, wr = wid >> 2, wc = wid & 3, fr = lane & 15, fq = lane >> 4;
    unsigned voffA[2], voffB[2];
#pragma unroll
    for (int i = 0; i < 2; ++i) { int R, C; stage_rc(tid * 16 + i * 8192, R, C); const int Rb = Epi::BADJ ? (R >> 5) * 64 + perm32(R & 31) : (R & ~31) + perm32(R & 31); voffA[i] = (unsigned)(R * lda + C) * 2u; voffB[i] = (unsigned)(Rb * ldb + C) * 2u; }
    const size_t kstep = (size_t)(BK * 2);
    const size_t hstepA = (size_t)HALF * lda * 2, hstepB = (size_t)(Epi::BADJ ? 32 : HALF) * ldb * 2;
    const unsigned ldsw = (unsigned)wid * 1024u;
    const int aoff = lds_byte(wr * 64 + fr, fq * 8), boff = lds_byte(wc * 32 + fr, fq * 8);
#define PG8_SA(b, h) (((b) * 2 + (h)) * HTB)
#define PG8_SB(b, h) ((4 + (b) * 2 + (h)) * HTB)
#define PG8_STAGE(bufoff, gbase, voff) do { _Pragma("unroll") for (int _i = 0; _i < 2; ++_i) \
        __builtin_amdgcn_global_load_lds((const unsigned*)((const char*)(gbase) + (voff)[_i]), (LAS unsigned*)(lds + (bufoff) + ldsw + _i * 8192), 16, 0, 0); } while (0)
#define PG8_LDA(dst, b, h) do { _Pragma("unroll") for (int m = 0; m < 4; ++m) _Pragma("unroll") for (int k = 0; k < 2; ++k) dst[m][k] = *(const LAS bf16x8*)(lds + PG8_SA(b, h) + aoff + m * 2048 + k * 1024); } while (0)
#define PG8_LDB(dst, b, h) do { _Pragma("unroll") for (int n = 0; n < 2; ++n) _Pragma("unroll") for (int k = 0; k < 2; ++k) dst[n][k] = *(const LAS bf16x8*)(lds + PG8_SB(b, h) + boff + n * 2048 + k * 1024); } while (0)
#define PG8_MMA(ai, bj, At, Bt) do { __builtin_amdgcn_s_setprio(1); _Pragma("unroll") for (int m = 0; m < 4; ++m) _Pragma("unroll") for (int n = 0; n < 2; ++n) _Pragma("unroll") for (int k = 0; k < 2; ++k) \
        acc[ai][bj][m][n] = __builtin_amdgcn_mfma_f32_16x16x32_bf16(Bt[n][k], At[m][k], acc[ai][bj][m][n], 0, 0, 0); __builtin_amdgcn_s_setprio(0); } while (0)
#define PG8_WAIT_V(n) asm volatile("s_waitcnt vmcnt(" #n ")" ::: "memory")
#define PG8_WAIT_L(n) asm volatile("s_waitcnt lgkmcnt(" #n ")" ::: "memory")
#define PG8_WAIT_V8R(flag) do { \
        if constexpr (Epi::NST == 16) asm volatile("s_cmp_lg_u32 %0, 0\n\ts_cbranch_scc0 .Lnr%=\n\ts_waitcnt vmcnt(24)\n\ts_branch .Ldn%=\n.Lnr%=:\n\ts_waitcnt vmcnt(8)\n.Ldn%=:" :: "s"(flag) : "memory", "scc"); \
        else if constexpr (Epi::NST == 32) asm volatile("s_cmp_lg_u32 %0, 0\n\ts_cbranch_scc0 .Lnr%=\n\ts_waitcnt vmcnt(40)\n\ts_branch .Ldn%=\n.Lnr%=:\n\ts_waitcnt vmcnt(8)\n.Ldn%=:" :: "s"(flag) : "memory", "scc"); \
        else PG8_WAIT_V(8); } while (0)
#define PG8_BAR __builtin_amdgcn_s_barrier()
#define PG8_SCHED __builtin_amdgcn_sched_barrier(0)
    Unit cur, nxt; int ui = 0;
    if (!S.next(0, cur)) return;
    f32x4 acc[2][2][4][2];
#pragma unroll
    for (int a = 0; a < 2; ++a)
#pragma unroll
        for (int b = 0; b < 2; ++b)
#pragma unroll
            for (int m = 0; m < 4; ++m)
#pragma unroll
                for (int n = 0; n < 2; ++n) acc[a][b][m][n] = (f32x4){0.f, 0.f, 0.f, 0.f};
    bf16x8 At[4][2], B0[2][2], B1[2][2];
    const char* cA = cur.a; const char* cB = cur.b;
    if constexpr (SP2) {
        PG8_STAGE(PG8_SB(0, 0), cB, voffB); PG8_STAGE(PG8_SB(0, 1), cB + hstepB, voffB); PG8_STAGE(PG8_SA(0, 0), cA, voffA); PG8_STAGE(PG8_SA(0, 1), cA + hstepA, voffA);
        if (wr == 1) PG8_BAR;
        PG8_WAIT_V(2); PG8_BAR;
        PG8_STAGE(PG8_SB(1, 0), cB + kstep, voffB); PG8_STAGE(PG8_SA(1, 0), cA + kstepA, voffA); PG8_STAGE(PG8_SB(1, 1), cB + hstepB + kstep, voffB);
        PG8_WAIT_V(6); PG8_BAR;
    } else {
        PG8_STAGE(PG8_SB(0, 0), cB, voffB); PG8_STAGE(PG8_SA(0, 0), cA, voffA); PG8_STAGE(PG8_SB(0, 1), cB + hstepB, voffB); PG8_STAGE(PG8_SA(0, 1), cA + hstepA, voffA);
        if (wr == 1) PG8_BAR;
        PG8_WAIT_V(4); PG8_BAR;
        PG8_STAGE(PG8_SB(1, 0), cB + kstep, voffB); PG8_STAGE(PG8_SA(1, 0), cA + kstepA, voffA); PG8_STAGE(PG8_SB(1, 1), cB + hstepB + kstep, voffB);
        PG8_WAIT_V(6); PG8_BAR;
    }
    int relax = 0;
    for (;;) {
        const int rs = relax;
        const bool has_next = S.next(ui + 1, nxt);
        const char* nA = has_next ? nxt.a : cA; const char* nB = has_next ? nxt.b : cB;
        for (int t = 0; t < nt; t += 2) {
            const bool last = (t == nt - 2);
            const char* aT = cA + (size_t)(t >> 1) * kstep2A;
            const char* a1 = aT + kstepA;
            const char* a2 = last ? nA : aT + kstep2A; const char* b2 = last ? nB : cB + (size_t)(t + 2) * kstep;
            const char* a3 = a2 + kstepA; const char* b3 = b2 + kstep;
            if constexpr (SP2) {
            const int rf = __builtin_amdgcn_readfirstlane((t == 0) ? rs : 0);
            PG8_LDB(B0, 0, 0); PG8_LDB(B1, 0, 1); PG8_SCHED; PG8_LDA(At, 0, 0); PG8_STAGE(PG8_SA(1, 1), a1 + hstepA, voffA);
            PG8_WAIT_V8R(rf); PG8_WAIT_L(0); PG8_BAR; PG8_MMA(0, 0, At, B0); PG8_MMA(0, 1, At, B1); PG8_BAR; PG8_SCHED;
            PG8_LDA(At, 0, 1); PG8_STAGE(PG8_SB(0, 0), b2, voffB); PG8_STAGE(PG8_SB(0, 1), b2 + hstepB, voffB); PG8_STAGE(PG8_SA(0, 0), a2, voffA);
            PG8_WAIT_V8R(rf); PG8_WAIT_L(0); PG8_BAR; PG8_MMA(1, 0, At, B0); PG8_MMA(1, 1, At, B1); PG8_BAR; PG8_SCHED;
            PG8_LDB(B0, 1, 0); PG8_LDB(B1, 1, 1); PG8_SCHED; PG8_LDA(At, 1, 0); PG8_STAGE(PG8_SA(0, 1), a2 + hstepA, voffA);
            PG8_WAIT_V(8); PG8_WAIT_L(0); PG8_BAR; PG8_MMA(0, 0, At, B0); PG8_MMA(0, 1, At, B1); PG8_BAR; PG8_SCHED;
            PG8_LDA(At, 1, 1); PG8_STAGE(PG8_SB(1, 0), b3, voffB); PG8_STAGE(PG8_SB(1, 1), b3 + hstepB, voffB); PG8_STAGE(PG8_SA(1, 0), a3, voffA);
            PG8_WAIT_V(8); PG8_WAIT_L(0); PG8_BAR; PG8_MMA(1, 0, At, B0); PG8_MMA(1, 1, At, B1); PG8_BAR; PG8_SCHED;
            } else {
            PG8_LDB(B0, 0, 0); PG8_SCHED; PG8_LDA(At, 0, 0); PG8_STAGE(PG8_SA(1, 1), a1 + hstepA, voffA);
            PG8_WAIT_L(8); PG8_BAR; PG8_WAIT_L(0); PG8_MMA(0, 0, At, B0); PG8_BAR; PG8_SCHED;
            PG8_LDB(B1, 0, 1); PG8_STAGE(PG8_SB(0, 0), b2, voffB);
            PG8_BAR; PG8_WAIT_L(0); PG8_MMA(0, 1, At, B1); PG8_BAR;
            PG8_LDA(At, 0, 1); PG8_STAGE(PG8_SA(0, 0), a2, voffA);
            PG8_BAR; PG8_WAIT_L(0); PG8_MMA(1, 0, At, B0); PG8_BAR; PG8_SCHED;
            PG8_STAGE(PG8_SB(0, 1), b2 + hstepB, voffB);
            PG8_WAIT_V(6); PG8_BAR; PG8_MMA(1, 1, At, B1); PG8_BAR;
            PG8_LDB(B0, 1, 0); PG8_SCHED; PG8_LDA(At, 1, 0); PG8_STAGE(PG8_SA(0, 1), a2 + hstepA, voffA);
            PG8_WAIT_L(8); PG8_BAR; PG8_WAIT_L(0); PG8_MMA(0, 0, At, B0); PG8_BAR; PG8_SCHED;
            PG8_LDB(B1, 1, 1); PG8_STAGE(PG8_SB(1, 0), b3, voffB);
            PG8_BAR; PG8_WAIT_L(0); PG8_MMA(0, 1, At, B1); PG8_BAR;
            PG8_LDA(At, 1, 1); PG8_STAGE(PG8_SA(1, 0), a3, voffA);
            PG8_BAR; PG8_WAIT_L(0); PG8_MMA(1, 0, At, B0); PG8_BAR; PG8_SCHED;
            PG8_STAGE(PG8_SB(1, 1), b3 + hstepB, voffB);
            PG8_WAIT_V(6); PG8_BAR; PG8_MMA(1, 1, At, B1); PG8_BAR;
            }
        }
        if constexpr (ALIGN_EPI) { if (wr == 0) PG8_BAR; }
        const int te = lane_id();
        const bool rst = E(acc, cur, wr, wc, te & 15, te >> 4);
        relax = E.stores(cur) ? 1 : 0;
        if (!has_next) break;
        if (rst) {
#pragma unroll
            for (int a = 0; a < 2; ++a)
#pragma unroll
                for (int b = 0; b < 2; ++b)
#pragma unroll
                    for (int m = 0; m < 4; ++m)
#pragma unroll
                        for (int n = 0; n < 2; ++n) acc[a][b][m][n] = (f32x4){0.f, 0.f, 0.f, 0.f};
        }
        cur = nxt; cA = nA; cB = nB; ++ui;
        if constexpr (ALIGN_EPI) { if (wr == 1) PG8_BAR; }
    }
    PG8_WAIT_V(0);
    if constexpr (!ALIGN_EPI) { if (wr == 0) PG8_BAR; }
    PG8_BAR;
#undef PG8_SA
#undef PG8_SB
#undef PG8_STAGE
#undef PG8_LDA
#undef PG8_LDB
#undef PG8_MMA
#undef PG8_WAIT_V
#undef PG8_WAIT_L
#undef PG8_WAIT_V8R
#undef PG8_BAR
#undef PG8_SCHED
}
}

typedef f32x4 Acc[2][2][4][2];

DI unsigned dpp_ror8(unsigned keep, unsigned src, const bool hi_half) {
    return hi_half ? (unsigned)__builtin_amdgcn_update_dpp((int)keep, (int)src, 0x128, 0xf, 0xc, false) : (unsigned)__builtin_amdgcn_update_dpp((int)keep, (int)src, 0x128, 0xf, 0x3, false);
}
DI void pair_rows(u32x4& w0, u32x4& w1) {
    u32x4 a, b;
    a.x = dpp_ror8(w0.x, w1.x, true); a.y = dpp_ror8(w0.y, w1.y, true); a.z = dpp_ror8(w0.z, w1.z, true); a.w = dpp_ror8(w0.w, w1.w, true);
    b.x = dpp_ror8(w1.x, w0.x, false); b.y = dpp_ror8(w1.y, w0.y, false); b.z = dpp_ror8(w1.z, w0.z, false); b.w = dpp_ror8(w1.w, w0.w, false);
    w0 = a; w1 = b;
}
DI void pair_rows(f32x4& v0, f32x4& v1) {
    u32x4 a = __builtin_bit_cast(u32x4, v0), b = __builtin_bit_cast(u32x4, v1);
    pair_rows(a, b);
    v0 = __builtin_bit_cast(f32x4, a); v1 = __builtin_bit_cast(f32x4, b);
}

struct EpiProj {
    bf16_t* PX; bf16_t* QH; const float* tab; LAS unsigned char* tl;
    mutable int tpm;
    static constexpr int NST = 16;
    static constexpr bool BADJ = true;
    DI bool stores(const pg8::Unit&) const { return true; }
    DI bool operator()(Acc& acc, const pg8::Unit& u, int wr, int wc, int fr, int fq) const {
        asm volatile("" : "+v"(fr), "+v"(fq));
        const int sec = u.pn >> 2;
        const bool ropet = (sec == 1 || sec == 2);
        if (ropet && tpm != u.pm) {
            tpm = u.pm;
            const int t = (wr * 4 + wc) * 64 + fq * 16 + fr;
            const int row = t >> 1, half = t & 1;
            const f32x4* src = (const f32x4*)(tab + (size_t)(u.pm * 256 + row) * 32 + half * 16);
            const f32x4 a = src[0], b = src[1], c = src[2], d = src[3];
            u32x4 w0, w1;
            w0.x = pk2(a[0], a[1]); w0.y = pk2(a[2], a[3]); w0.z = pk2(b[0], b[1]); w0.w = pk2(b[2], b[3]);
            w1.x = pk2(c[0], c[1]); w1.y = pk2(c[2], c[3]); w1.z = pk2(d[0], d[1]); w1.w = pk2(d[2], d[3]);
            *(LAS u32x4*)(tl + row * 64 + half * 32) = w0; *(LAS u32x4*)(tl + row * 64 + half * 32 + 16) = w1;
            __syncthreads();
        }
        const bool rope = ropet && (wc & 1) == 0;
        bf16_t* rp0; constexpr size_t rstep = 128;
        {
            const int row = u.pm * 256 + wr * 64 + (fr & 7), cw = wc * 64 + (fr >> 3) * 32 + fq * 8;
            const int dsec = sec == 0 ? 0 : sec >= 4 ? sec - 3 : sec + 2;
            rp0 = PX + (size_t)dsec * SECN + hmrow(row >> 13, (u.pn & 3) * 2 + (wc >> 1), (size_t)(row & (SEQ - 1))) + (cw & 127);
        }
#pragma unroll
        for (int ai = 0; ai < 2; ++ai)
#pragma unroll
            for (int m = 0; m < 4; ++m) {
                const int rl = ai * 128 + wr * 64 + m * 16 + fr;
                u32x4 wst[2];
                u32x4 cs0 = {0u, 0u, 0u, 0u}, cs1 = cs0;
                if (rope) { cs0 = *(const LAS u32x4*)(tl + rl * 64 + (fq & 1) * 32); cs1 = *(const LAS u32x4*)(tl + rl * 64 + (fq & 1) * 32 + 16); }
#pragma unroll
                for (int bj = 0; bj < 2; ++bj) {
                    f32x4 v0 = acc[ai][bj][m][0], v1 = acc[ai][bj][m][1];
                    if (bj == 0 && rope) {
                        f32x4 p0, p1;
#pragma unroll
                        for (int j = 0; j < 4; ++j) { p0[j] = __shfl_xor(v0[j], 32); p1[j] = __shfl_xor(v1[j], 32); }
                        const float sg = (fq & 2) ? 1.0f : -1.0f;
#pragma unroll
                        for (int j = 0; j < 4; ++j) {
                            v0[j] = v0[j] * bflo(cs0[j]) + sg * p0[j] * bfhi(cs0[j]);
                            v1[j] = v1[j] * bflo(cs1[j]) + sg * p1[j] * bfhi(cs1[j]);
                        }
                    }
                    if (sec >= 4) {
#pragma unroll
                        for (int j = 0; j < 4; ++j) { v0[j] *= fsig(v0[j]); v1[j] *= fsig(v1[j]); }
                    }
                    u32x4 w; w.x = pk2(v0[0], v0[1]); w.y = pk2(v0[2], v0[3]); w.z = pk2(v1[0], v1[1]); w.w = pk2(v1[2], v1[3]);
                    wst[bj] = w;
                }
                pair_rows(wst[0], wst[1]);
                bf16_t* rp = rp0 + (size_t)(ai * 128 + m * 16) * rstep;
                __builtin_nontemporal_store(wst[0], (u32x4*)rp);
                __builtin_nontemporal_store(wst[1], (u32x4*)(rp + 8 * rstep));
            }
        return true;
    }
};
struct EpiGate {
    bf16_t* KH; const float* bias; LAS unsigned char* sl;
    static constexpr int NST = 16;
    static constexpr bool BADJ = false;
    DI bool stores(const pg8::Unit&) const { return true; }
    DI bool operator()(Acc& acc, const pg8::Unit& u, int wr, int wc, int fr, int fq) const {
        const int lane = fq * 16 + fr;
        LAS float* bl = (LAS float*)sl + (wr * 4 + wc) * 64;
        bl[lane] = bias[(lane >> 5) * 1024 + u.pn * 128 + wc * 32 + (lane & 31)];
#pragma unroll
        for (int ai = 0; ai < 2; ++ai)
#pragma unroll
            for (int m = 0; m < 4; ++m) {
                bf16_t* rp = KH + ((size_t)((u.pm * 8 + u.pn) * 16 + ai * 8 + wr * 4 + m) * 4 + wc) * 512 + fr * 32 + fq * 8;
                float sr[8], sa[8];
                int bo = fq * 8; asm volatile("" : "+v"(bo));
#pragma unroll
                for (int n = 0; n < 2; ++n) {
                    const f32x4 vr = acc[ai][0][m][n] + *(const LAS f32x4*)(bl + bo + n * 4), va = acc[ai][1][m][n] + *(const LAS f32x4*)(bl + 32 + bo + n * 4);
#pragma unroll
                    for (int j = 0; j < 4; ++j) {
                        const float er = 1.0f + __builtin_amdgcn_exp2f(-1.4426950408889634f * vr[j]), ea = 1.0f + __builtin_amdgcn_exp2f(-1.4426950408889634f * va[j]);
                        sa[n * 4 + j] = __builtin_amdgcn_rcpf(ea);
                        sr[n * 4 + j] = ea * __builtin_amdgcn_rcpf(er);
                    }
                }
                u32x4 w; w.x = pk2(sr[0], sr[1]); w.y = pk2(sr[2], sr[3]); w.z = pk2(sr[4], sr[5]); w.w = pk2(sr[6], sr[7]);
                __builtin_nontemporal_store(w, (u32x4*)rp);
                w.x = pk2(sa[0], sa[1]); w.y = pk2(sa[2], sa[3]); w.z = pk2(sa[4], sa[5]); w.w = pk2(sa[6], sa[7]);
                __builtin_nontemporal_store(w, (u32x4*)(rp + (size_t)M * 1024));
            }
        return true;
    }
};
struct EpiMerged {
    bf16_t* QH;
    static constexpr int NST = 0;
    static constexpr bool BADJ = true;
    DI bool stores(const pg8::Unit&) const { return false; }
    DI bool operator()(Acc& acc, const pg8::Unit& u, int wr, int wc, int fr, int fq) const {
        const size_t goff = (u.sub == 0) ? (size_t)M * 1024 : (size_t)2 * M * 1024;
        bf16_t* rp0 = QH + (size_t)u.pm * (256 * 1024) + (size_t)(u.pn * 4 + wc) * (256 * 64) + (wr * 64 + (fr & 7)) * 64 + (fr >> 3) * 32 + fq * 8;
#pragma unroll
        for (int ai = 0; ai < 2; ++ai) {
            u32x4 gg[4][2];
#pragma unroll
            for (int m = 0; m < 4; ++m) {
                const bf16_t* gp = QH + goff + ((size_t)((u.pm * 8 + u.pn * 2 + (wc >> 1)) * 16 + ai * 8 + wr * 4 + m) * 4 + (wc & 1) * 2) * 512 + fr * 32 + fq * 8;
#pragma unroll
                for (int bj = 0; bj < 2; ++bj) gg[m][bj] = *(const u32x4*)(gp + bj * 512);
            }
#pragma unroll
            for (int m = 0; m < 4; ++m) {
                u32x4 wst[2];
#pragma unroll
                for (int bj = 0; bj < 2; ++bj) {
                    const u32x4 a = gg[m][bj];
                    f32x4 v0 = acc[ai][bj][m][0], v1 = acc[ai][bj][m][1];
                    v0[0] *= bflo(a.x); v0[1] *= bfhi(a.x); v0[2] *= bflo(a.y); v0[3] *= bfhi(a.y);
                    v1[0] *= bflo(a.z); v1[1] *= bfhi(a.z); v1[2] *= bflo(a.w); v1[3] *= bfhi(a.w);
                    if (u.sub == 0) { acc[ai][bj][m][0] = v0; acc[ai][bj][m][1] = v1; }
                    else { wst[bj].x = pk2(v0[0], v0[1]); wst[bj].y = pk2(v0[2], v0[3]); wst[bj].z = pk2(v1[0], v1[1]); wst[bj].w = pk2(v1[2], v1[3]); }
                }
                if (u.sub != 0) {
                    pair_rows(wst[0], wst[1]);
                    bf16_t* rp = rp0 + (ai * 128 + m * 16) * 64;
                    *(u32x4*)rp = wst[0]; *(u32x4*)(rp + 8 * 64) = wst[1];
                }
            }
        }
        return u.sub != 0;
    }
};
struct EpiOut {
    const float* x; const float* mod; const float* gfin; float* out; float* rowsq; unsigned* cnt; LAS unsigned char* sl;
    static constexpr int NST = 0;
    static constexpr bool BADJ = true;
    DI bool stores(const pg8::Unit&) const { return false; }
    DI bool operator()(Acc& acc, const pg8::Unit& u, int wr, int wc, int fr, int fq) const {
        asm volatile("" : "+v"(fr), "+v"(fq));
        const int col0 = u.pn * 256 + wc * 64 + fq * 8;
        const int wid = wr * 4 + wc, lane = fq * 16 + fr;
        LAS float* S = (LAS float*)sl;
        const size_t po = (size_t)(u.pm * 256 + wr * 64 + (fr & 7)) * D + u.pn * 256 + wc * 64 + fq * 8 + (fr >> 3) * 4;
        f32x4 gv[2][2];
        {
            const float* gp = mod + ((u.pm * 256) / SEQ) * 3072 + 2048 + col0;
#pragma unroll
            for (int bj = 0; bj < 2; ++bj)
#pragma unroll
                for (int n = 0; n < 2; ++n) gv[bj][n] = *(const f32x4*)(gp + bj * 32 + n * 4);
        }
        f32x4 xv[4][2][2]; float ssk[4];
        auto xload = [&](int ai) {
#pragma unroll
            for (int m = 0; m < 4; ++m) {
                const float* xp = x + po + (size_t)(ai * 128 + m * 16) * D;
#pragma unroll
                for (int bj = 0; bj < 2; ++bj) { xv[m][bj][0] = __builtin_nontemporal_load((const f32x4*)(xp + bj * 32)); xv[m][bj][1] = __builtin_nontemporal_load((const f32x4*)(xp + bj * 32 + 8 * D)); }
            }
        };
        auto xmath = [&](int ai) {
#pragma unroll
            for (int m = 0; m < 4; ++m) {
                float ss = 0.f;
#pragma unroll
                for (int bj = 0; bj < 2; ++bj) {
                    pair_rows(xv[m][bj][0], xv[m][bj][1]);
#pragma unroll
                    for (int n = 0; n < 2; ++n) {
                        const f32x4 o = xv[m][bj][n] + gv[bj][n] * acc[ai][bj][m][n];
                        ss += o[0] * o[0] + o[1] * o[1] + o[2] * o[2] + o[3] * o[3];
                        acc[ai][bj][m][n] = o;
                    }
                }
                ss += __shfl_xor(ss, 16); ssk[m] = half_sum(ss);
            }
        };
        auto xpub = [&](int ai) {
#pragma unroll
            for (int m = 0; m < 4; ++m) {
                const int row = u.pm * 256 + ai * 128 + wr * 64 + m * 16 + fr;
                if (fq == 0) __hip_atomic_store(rowsq + (size_t)row * 16 + u.pn * 4 + wc, ssk[m], __ATOMIC_RELAXED, __HIP_MEMORY_SCOPE_AGENT);
            }
        };
        xload(0); xmath(0);
        __builtin_amdgcn_sched_barrier(0);
        xload(1);
        __builtin_amdgcn_sched_barrier(0);
        xpub(0);
        xmath(1); xpub(1);
        asm volatile("s_waitcnt vmcnt(0)" ::: "memory");
        unsigned* pc = cnt + 64 * u.pm;
        if (lane == 0) __hip_atomic_fetch_add(pc, 1u, __ATOMIC_RELAXED, __HIP_MEMORY_SCOPE_AGENT);
        if (wid == 0) {
            unsigned spins = 0;
            while ((unsigned)__builtin_amdgcn_readfirstlane(__hip_atomic_load(pc, __ATOMIC_RELAXED, __HIP_MEMORY_SCOPE_AGENT)) < 32u) {
                __builtin_amdgcn_s_sleep(2);
                if (++spins > (1u << 24)) break;
            }
            __builtin_amdgcn_fence(__ATOMIC_ACQUIRE, "agent");
            asm volatile("s_waitcnt vmcnt(0)" ::: "memory");
        }
        __syncthreads();
        const int tix = wid * 64 + lane;
        if (tix < 256) {
            const f32x4* sp = (const f32x4*)(rowsq + (size_t)(u.pm * 256 + tix) * 16);
            const f32x4 a = sp[0], b2 = sp[1], c2 = sp[2], d2 = sp[3];
            const float t = (a[0] + a[1] + a[2] + a[3]) + (b2[0] + b2[1] + b2[2] + b2[3]) + (c2[0] + c2[1] + c2[2] + c2[3]) + (d2[0] + d2[1] + d2[2] + d2[3]);
            S[tix] = rsqrtf(t * (1.0f / D) + 1e-6f);
        }
        __syncthreads();
        f32x4 gf[2][2];
#pragma unroll
        for (int bj = 0; bj < 2; ++bj)
#pragma unroll
            for (int n = 0; n < 2; ++n) gf[bj][n] = *(const f32x4*)(gfin + col0 + bj * 32 + n * 4);
#pragma unroll
        for (int ai = 0; ai < 2; ++ai)
#pragma unroll
            for (int m = 0; m < 4; ++m) {
                const int rl = ai * 128 + wr * 64 + m * 16 + fr;
                const float rs = S[rl];
                float* op = out + po + (size_t)(ai * 128 + m * 16) * D;
#pragma unroll
                for (int bj = 0; bj < 2; ++bj) {
                    f32x4 o0 = acc[ai][bj][m][0] * rs * gf[bj][0], o1 = acc[ai][bj][m][1] * rs * gf[bj][1];
                    pair_rows(o0, o1);
                    __builtin_nontemporal_store(o0, (f32x4*)(op + bj * 32)); __builtin_nontemporal_store(o1, (f32x4*)(op + bj * 32 + 8 * D));
                }
            }
        return true;
    }
};

DI void transpose_tile(const float* src, int lds_, int col0, int k0, bf16_t* dst, int ldd, int n0, float scale, float* tile, const int wv) {
    const int tid = TIDX(wv);
    {
        const int k = tid >> 3, n8 = (tid & 7) * 8;
        const float4 a = *(const float4*)(src + (size_t)(k0 + k) * lds_ + col0 + n8);
        const float4 b = *(const float4*)(src + (size_t)(k0 + k) * lds_ + col0 + n8 + 4);
        float* t = tile + k * 65 + n8;
        t[0] = a.x; t[1] = a.y; t[2] = a.z; t[3] = a.w; t[4] = b.x; t[5] = b.y; t[6] = b.z; t[7] = b.w;
    }
    __syncthreads();
    {
        const int n = tid >> 3, k8 = (tid & 7) * 8;
        u32x4 w;
        w.x = pk2(tile[(k8 + 0) * 65 + n] * scale, tile[(k8 + 1) * 65 + n] * scale); w.y = pk2(tile[(k8 + 2) * 65 + n] * scale, tile[(k8 + 3) * 65 + n] * scale);
        w.z = pk2(tile[(k8 + 4) * 65 + n] * scale, tile[(k8 + 5) * 65 + n] * scale); w.w = pk2(tile[(k8 + 6) * 65 + n] * scale, tile[(k8 + 7) * 65 + n] * scale);
        *(u32x4*)(dst + (size_t)(n0 + n) * ldd + k0 + k8) = w;
    }
    __syncthreads();
}

DI void transpose_tile4(const float* src, int lds_, int col0, int hstep, int k0, bf16_t* dst, int ldd, int n0, float scale, float* tile, const int wv) {
    const int tid = TIDX(wv);
    {
        const int k = tid >> 3, n8 = (tid & 7) * 8;
        float4 a[4], b[4];
#pragma unroll
        for (int j = 0; j < 4; ++j) {
            const float* sp = src + (size_t)(k0 + k) * lds_ + col0 + (j & 1) * 64 + (j >> 1) * hstep + n8;
            a[j] = *(const float4*)sp; b[j] = *(const float4*)(sp + 4);
        }
#pragma unroll
        for (int j = 0; j < 4; ++j) {
            float* t = tile + j * (64 * 65) + k * 65 + n8;
            t[0] = a[j].x; t[1] = a[j].y; t[2] = a[j].z; t[3] = a[j].w; t[4] = b[j].x; t[5] = b[j].y; t[6] = b[j].z; t[7] = b[j].w;
        }
    }
    __syncthreads();
    {
        const int n = tid >> 3, k8 = (tid & 7) * 8;
#pragma unroll
        for (int j = 0; j < 4; ++j) {
            const float* t = tile + j * (64 * 65) + n;
            u32x4 w;
            w.x = pk2(t[(k8 + 0) * 65] * scale, t[(k8 + 1) * 65] * scale); w.y = pk2(t[(k8 + 2) * 65] * scale, t[(k8 + 3) * 65] * scale);
            w.z = pk2(t[(k8 + 4) * 65] * scale, t[(k8 + 5) * 65] * scale); w.w = pk2(t[(k8 + 6) * 65] * scale, t[(k8 + 7) * 65] * scale);
            *(u32x4*)(dst + (size_t)(n0 + j * 64 + n) * ldd + k0 + k8) = w;
        }
    }
    __syncthreads();
}

DI void mod_task(const Params& p, int task, float* sm, const int wv) {
    float* cact = sm;
    float* red = sm + 8 * 1024;
    const int tid = TIDX(wv);
    {
        float cv[16];
#pragma unroll
        for (int i = 0; i < 16; ++i) cv[i] = p.c[tid + i * 512];
#pragma unroll
        for (int i = 0; i < 16; ++i) cact[tid + i * 512] = cv[i] * fsig(cv[i]);
    }
    __syncthreads();
    const int cl = tid & 15, col = task * 16 + cl, ks = tid >> 4;
    float acc[8];
#pragma unroll
    for (int b = 0; b < 8; ++b) acc[b] = 0.f;
    {
        float wv_[32];
#pragma unroll
        for (int k = 0; k < 32; ++k) wv_[k] = p.w_mod[(size_t)(ks * 32 + k) * 3072 + col];
#pragma unroll
        for (int k = 0; k < 32; ++k)
#pragma unroll
            for (int b = 0; b < 8; ++b) acc[b] += cact[b * 1024 + ks * 32 + k] * wv_[k];
    }
#pragma unroll
    for (int b = 0; b < 8; ++b) red[(ks * 16 + cl) * 8 + b] = acc[b];
    __syncthreads();
    if (tid < 128) {
        const int cc = tid & 15, b = tid >> 4;
        float s = 0.f;
#pragma unroll
        for (int k2 = 0; k2 < 32; ++k2) s += red[(k2 * 16 + cc) * 8 + b];
        float* mod = (float*)(p.ws + OFF_MOD);
        mod[b * 3072 + task * 16 + cc] = s + p.b_mod[task * 16 + cc];
    }
    __syncthreads();
}

DI void phase_prologue(const Params& p, float* sm, const int wv) {
    constexpr int T_WIN = 24 * 16, T_WGL = 8 * 16, T_SQ = 4 * 16, T_WGT = 64, T_MOD = 192;
    constexpr int E0 = T_WIN, E1 = E0 + T_WGL, E2 = E1 + T_SQ, E3 = E2 + T_SQ, E4 = E3 + T_SQ, E5 = E4 + T_WGT, E6 = E5 + T_MOD, E7 = E6 + 1;
    for (int t0 = blockIdx.x; t0 < E7; t0 += gridDim.x) {
        const int t = t0 < T_MOD ? E5 + t0 : t0 < E5 + T_MOD ? t0 - T_MOD : t0;
        if (t < E0) {
            const int pn = t >> 4, kt = t & 15, sec = pn >> 2;
            const int wbase = (sec == 0 ? 0 : sec == 1 ? 2048 : sec == 2 ? 3072 : sec == 3 ? 4096 : sec == 4 ? 1024 : 5120) + (pn & 3) * 256;
            transpose_tile4(p.w_in, 8192, wbase, 128, kt * 64, (bf16_t*)(p.ws + OFF_WINT), 1024, pn * 256, sec == 1 ? QSCALE : 1.0f, sm, wv);
        } else if (t < E1) {
            const int u = t - E0, pn = u >> 4, kt = u & 15;
            transpose_tile4(p.w_in, 8192, 6144 + pn * 128, 1024, kt * 64, (bf16_t*)(p.ws + OFF_WGL), 1024, pn * 256, 1.0f, sm, wv);
        } else if (t < E4) {
            const int which = t < E2 ? 0 : t < E3 ? 1 : 2;
            const int u = t - (which == 0 ? E1 : which == 1 ? E2 : E3), pn = u >> 4, kt = u & 15;
            const float* src = which == 0 ? p.w_out_rnn : which == 1 ? p.w_out_attn : p.w_o;
            bf16_t* dst = (bf16_t*)(p.ws + (which == 0 ? OFF_WR : which == 1 ? OFF_WA : OFF_WO));
            transpose_tile4(src, 1024, pn * 256, 128, kt * 64, dst, 1024, pn * 256, 1.0f, sm, wv);
        } else if (t < E5) {
            const int u = t - E4, hb = u >> 3, g = (u >> 2) & 1, nt2 = (u >> 1) & 1, kt = u & 1;
            const float* src = (g ? p.w_x : p.w_a) + hb * 16384;
            bf16_t* dst = (bf16_t*)(p.ws + OFF_WGT) + hb * 256 * 128;
            transpose_tile(src, 128, nt2 * 64, kt * 64, dst, 128, g * 128 + nt2 * 64, -1.4426950408889634f, sm, wv);
        } else if (t < E6) {
            mod_task(p, t - E5, sm, wv);
            asm volatile("s_waitcnt vmcnt(0)" ::: "memory");
            __syncthreads();
            if (TIDX(wv) == 0) {
                __builtin_amdgcn_fence(__ATOMIC_RELEASE, "agent");
                asm volatile("s_waitcnt vmcnt(0)" ::: "memory");
                __hip_atomic_fetch_add((unsigned*)(p.ws + OFF_BAR) + MOD_CNT_WORD, 1u, __ATOMIC_RELAXED, __HIP_MEMORY_SCOPE_AGENT);
            }
        } else {
            float* sp = (float*)(p.ws + OFF_SP);
            for (int i = TIDX(wv); i < 1024; i += 512) sp[i] = -8.0f * log1pf(__expf(-p.lam[i]));
        }
    }
}

DI void phase_h(const Params& p, const int wv) {
    const int lane = lane_id(), wid = wv;
    const float* mod = (const float*)(p.ws + OFF_MOD);
    const int G_ = (int)gridDim.x, g0 = (int)blockIdx.x, g1 = M / 16;
    if (g0 >= g1) return;
    auto loadx = [&](f32x4 (&d)[2][4], int r16) {
        const int row0 = r16 * 16 + wid * 2;
#pragma unroll
        for (int rr = 0; rr < 2; ++rr)
#pragma unroll
            for (int i = 0; i < 4; ++i) d[rr][i] = __builtin_nontemporal_load((const f32x4*)(p.x + (size_t)(row0 + rr) * D + i * 256 + lane * 4));
    };
    f32x4 gs[4], sh[4]; int bcur = -1;
    f32x4 v[2][4], vn[2][4];
    loadx(v, g0);
    for (int r16 = g0; r16 < g1; r16 += G_) {
        const int row0 = r16 * 16 + wid * 2;
        const int b = row0 / SEQ;
        if (b != bcur) {
            bcur = b;
#pragma unroll
            for (int i = 0; i < 4; ++i) {
                const int c0 = i * 256 + lane * 4;
                const f32x4 g = *(const f32x4*)(p.g_norm + c0), sc = *(const f32x4*)(mod + b * 3072 + 1024 + c0);
                gs[i] = g * (1.0f + sc); sh[i] = *(const f32x4*)(mod + b * 3072 + c0);
            }
        }
        if (r16 + G_ < g1) loadx(vn, r16 + G_);
        float ss[2] = {0.f, 0.f};
#pragma unroll
        for (int rr = 0; rr < 2; ++rr) {
#pragma unroll
            for (int i = 0; i < 4; ++i) ss[rr] += v[rr][i][0] * v[rr][i][0] + v[rr][i][1] * v[rr][i][1] + v[rr][i][2] * v[rr][i][2] + v[rr][i][3] * v[rr][i][3];
            ss[rr] = wave_sum(ss[rr]);
        }
#pragma unroll
        for (int rr = 0; rr < 2; ++rr) {
            const float rstd = rsqrtf(ss[rr] * (1.0f / D) + 1e-6f);
#pragma unroll
            for (int i = 0; i < 4; ++i) {
                const f32x4 o4 = v[rr][i] * rstd * gs[i] + sh[i];
                u32x2 o; o.x = pk2(o4[0], o4[1]); o.y = pk2(o4[2], o4[3]);
                *(u32x2*)((bf16_t*)(p.ws + OFF_H) + (size_t)(row0 + rr) * D + i * 256 + lane * 4) = o;
            }
        }
#pragma unroll
        for (int rr = 0; rr < 2; ++rr)
#pragma unroll
            for (int i = 0; i < 4; ++i) v[rr][i] = vn[rr][i];
    }
    {
        float2* tab = (float2*)(p.ws + OFF_ROPE);
        const int ngrp = (g1 - g0 + G_ - 1) / G_, tid = wid * 64 + lane;
        for (int e = tid; e < ngrp * 256; e += 512) {
            const int row = (g0 + (e >> 8) * G_) * 16 + ((e >> 4) & 15), f = e & 15;
            const float ang = (float)p.pos[row] * p.inv_freq[f];
            float s, c; sincosf(ang, &s, &c);
            tab[(size_t)row * 16 + f] = make_float2(c, s);
        }
    }
}

typedef float f32x16 __attribute__((ext_vector_type(16)));
DI int crow(int r, int hi) { return (r & 3) + 8 * (r >> 2) + 4 * hi; }
constexpr int RS = 272;
constexpr int R_WG = 0, R_XC = 256 * RS, R_Z = R_XC + 128 * RS, R_SUMS = R_Z + 32768, R_CAR = R_SUMS + 4096;

template <bool PASS2> DI void phase_rnn(const Params& p, unsigned char* lds, const int wv, const int stage) {
    LAS unsigned char* l3 = (LAS unsigned char*)lds;
    int tid = TIDX(wv); asm volatile("" : "+v"(tid));
    const int lane = tid & 63, wid = wv, wt = wid & 3, wch = wid >> 2, l31 = lane & 31, h2 = lane >> 5;
    bf16_t* PX = (bf16_t*)(p.ws + OFF_PX);
    float* SUMA = (float*)(p.ws + OFF_SUM); float* SUMB = SUMA + 8 * 64 * 1024;
    const float* sp = (const float*)(p.ws + OFF_SP);
    LAS float* SUMS = (LAS float*)(l3 + R_SUMS);
    LAS float* CAR = (LAS float*)(l3 + R_CAR);
    for (int strip = blockIdx.x; strip < 256; strip += gridDim.x) {
        const int hb = strip & 7, jj = strip >> 3, b = jj >> 2, q = jj & 3;
        if (stage == 3 && PASS2 != (q == 0)) continue;
        const int ck0 = (stage == 3) ? (PASS2 ? 0 : 12 + 13 * (q - 1)) : 12 + 13 * q, nck = (stage == 3 && PASS2) ? 12 : 13;
        __syncthreads();
        {
            const bf16_t* wg = (const bf16_t*)(p.ws + OFF_WGT) + hb * 256 * 128;
            const unsigned woff = (unsigned)(((tid >> 4) * 128 + (tid & 15) * 8) * 2), wlds = (unsigned)(R_WG + (tid >> 4) * RS + (tid & 15) * 16);
#pragma unroll
            for (int i = 0; i < 8; ++i) {
                const u32x4 v = *(const u32x4*)((const char*)wg + woff + i * 8192u);
                *(LAS u32x4*)(l3 + wlds + i * (32 * RS)) = v;
            }
        }
        unsigned bxc[2], bzz[2];
#pragma unroll
        for (int nt = 0; nt < 2; ++nt) {
            bxc[nt] = R_XC + (wt * 32 + 4 * h2) * RS + (wch * 64 + nt * 32 + l31) * 2;
            bzz[nt] = R_Z + (wt * 32 + 4 * h2) * 256 + (wch * 64 + nt * 32 + l31) * 2;
        }
        float ba[2], bxv[2], spl[2];
#pragma unroll
        for (int nt = 0; nt < 2; ++nt) { const int ch = hb * 128 + wch * 64 + nt * 32 + l31; ba[nt] = __builtin_amdgcn_exp2f(-1.4426950408889634f * p.b_a[ch]); bxv[nt] = __builtin_amdgcn_exp2f(-1.4426950408889634f * p.b_x[ch]);   spl[nt] = sp[ch] * 1.4426950408889634f; }
        if (PASS2) {
            if (tid < 128) {
                const int ch = hb * 128 + tid; float h = 0.f;
                for (int cc = 11; cc < ck0; cc += 8) {
                    float sa[8], sb[8];
#pragma unroll
                    for (int j = 0; j < 8; ++j) {
                        const bool in = cc + j < ck0; const size_t o = (size_t)(b * 64 + (in ? cc + j : cc)) * 1024 + ch;
                        sa[j] = SUMA[o]; sb[j] = SUMB[o];
                        if (!in) { sa[j] = 1.f; sb[j] = 0.f; }
                    }
#pragma unroll
                    for (int j = 0; j < 8; ++j) h = sa[j] * h + sb[j];
                }
                CAR[tid] = h;
            }
        }
        u32x4 xr[7], zr[4]; int posv = 1;
        const unsigned xoff = (unsigned)(((tid >> 4) * 4 * 128 + (tid & 15) * 8) * 2);
        const unsigned zoff = (unsigned)(((tid >> 4) * 128 + (tid & 15) * 8) * 2) + (unsigned)(PXS_ZR * 2);
        auto load_tile = [&](int tokb, int tt0) {
            asm volatile("" : "+s"(tokb));
            const char* tb = (const char*)(PX + PXS_XR + ((size_t)tokb + (size_t)(b * 7 + hb) * SEQ) * 128);
            const int tq = tid >> 4;
#pragma unroll
            for (int i = 0; i < 7; ++i) {
                if (tt0 + tq * 4 + i - 3 >= 0) xr[i] = *(const u32x4*)(tb + (ptrdiff_t)(i - 3) * 256 + xoff);
                else xr[i] = (u32x4){0u, 0u, 0u, 0u};
            }
            if (PASS2) {
#pragma unroll
                for (int i = 0; i < 4; ++i) zr[i] = *(const u32x4*)(tb + (size_t)i * (32 * 256) + zoff);
            }
            posv = p.pos[tokb + wt * 32 + l31];
        };
        load_tile(b * SEQ + ck0 * 128, ck0 * 128);
        for (int ci = 0; ci < nck; ++ci) {
            const int ck = ck0 + ci, t0 = ck * 128, tokbase = b * SEQ + t0;
            {
                const int ch8 = tid & 15, tq = tid >> 4;
                const float* cwp = p.conv_w + hb * 128 + ch8 * 8;
                f32x4 cw[4][2], cb[2];
#pragma unroll
                for (int k = 0; k < 4; ++k) { cw[k][0] = *(const f32x4*)(cwp + k * 1024); cw[k][1] = *(const f32x4*)(cwp + k * 1024 + 4); }
                cb[0] = *(const f32x4*)(p.conv_b + hb * 128 + ch8 * 8); cb[1] = *(const f32x4*)(p.conv_b + hb * 128 + ch8 * 8 + 4);
#pragma unroll
                for (int o = 0; o < 4; ++o) {
                    float y[8];
#pragma unroll
                    for (int e = 0; e < 8; ++e) y[e] = cb[e >> 2][e & 3];
#pragma unroll
                    for (int k = 0; k < 4; ++k) {
                        const u32x4 xv = xr[o + k];
#pragma unroll
                        for (int e2 = 0; e2 < 4; ++e2) {
                            const unsigned w = xv[e2];
                            y[2 * e2] += cw[k][(2 * e2) >> 2][(2 * e2) & 3] * __uint_as_float(w << 16);
                            y[2 * e2 + 1] += cw[k][(2 * e2 + 1) >> 2][(2 * e2 + 1) & 3] * __uint_as_float(w & 0xffff0000u);
                        }
                    }
                    const int tt = tq * 4 + o;
                    u32x4 w; w.x = pk2(y[0], y[1]); w.y = pk2(y[2], y[3]); w.z = pk2(y[4], y[5]); w.w = pk2(y[6], y[7]);
                    *(LAS u32x4*)(l3 + R_XC + tt * RS + ch8 * 16) = w;
                }
            }
            const unsigned rbh = ((unsigned)__ballot(posv == 0)) >> (4 * h2);
            if (PASS2) {
#pragma unroll
                for (int i = 0; i < 4; ++i) *(LAS u32x4*)(l3 + R_Z + (i * 32 + (tid >> 4)) * 256 + (tid & 15) * 16) = zr[i];
            }
            if (ci + 1 < nck) load_tile(tokbase + 128, t0 + 128);
            __syncthreads();
            f32x16 accA[2], accX[2];
#pragma unroll
            for (int nt = 0; nt < 2; ++nt)
#pragma unroll
                for (int r = 0; r < 16; ++r) { accA[nt][r] = 0.f; accX[nt][r] = 0.f; }
            {
                const unsigned abase = R_XC + (wt * 32 + l31) * RS + h2 * 16;
                const unsigned bbase = R_WG + (wch * 64 + l31) * RS + h2 * 16;
#pragma unroll
                for (int ks = 0; ks < 8; ++ks) {
                    const unsigned kb = (unsigned)(ks * 32);
                    const bf16x8 af = *(const LAS bf16x8*)(l3 + abase + kb);
#pragma unroll
                    for (int nt = 0; nt < 2; ++nt) {
                        const bf16x8 bA = *(const LAS bf16x8*)(l3 + bbase + nt * 32 * RS + kb);
                        const bf16x8 bX = *(const LAS bf16x8*)(l3 + bbase + (128 + nt * 32) * RS + kb);
                        accA[nt] = __builtin_amdgcn_mfma_f32_32x32x16_bf16(af, bA, accA[nt], 0, 0, 0);
                        accX[nt] = __builtin_amdgcn_mfma_f32_32x32x16_bf16(af, bX, accX[nt], 0, 0, 0);
                    }
                }
            }
#pragma unroll
            for (int r = 0; r < 16; ++r) {
                const float rpen = ((rbh >> ((r & 3) + 8 * (r >> 2))) & 1u) ? -__builtin_inff() : 0.0f;
#pragma unroll
                for (int nt = 0; nt < 2; ++nt) {
                    const float xcv = bf2f(*(const LAS bf16_t*)(l3 + bxc[nt] + ((r & 3) + 8 * (r >> 2)) * RS));
                    const float rr = __builtin_amdgcn_rcpf(__builtin_fmaf(__builtin_amdgcn_exp2f(accA[nt][r]), ba[nt], 1.0f)), ii = __builtin_amdgcn_rcpf(__builtin_fmaf(__builtin_amdgcn_exp2f(accX[nt][r]), bxv[nt], 1.0f));
                    const float a = __builtin_amdgcn_exp2f(__builtin_fmaf(spl[nt], rr, rpen));
                    const float mult = __builtin_amdgcn_sqrtf(fmaxf(1.0f - a * a, 0.f));
                    accA[nt][r] = a; accX[nt][r] = mult * ii * xcv;
                }
            }
            float loA[2][4], loB[2][4], hiA[2][4], hiB[2][4];
#pragma unroll
            for (int nt = 0; nt < 2; ++nt)
#pragma unroll
                for (int s4 = 0; s4 < 4; ++s4) {
                    float A = 1.f, B = 0.f;
#pragma unroll
                    for (int r4 = 0; r4 < 4; ++r4) { const float a = accA[nt][4 * s4 + r4]; B = a * B + accX[nt][4 * s4 + r4]; A *= a; }
                    half_split(A, loA[nt][s4], hiA[nt][s4]); half_split(B, loB[nt][s4], hiB[nt][s4]);
                }
#pragma unroll
            for (int nt = 0; nt < 2; ++nt) {
                float At = 1.f, Bt = 0.f;
#pragma unroll
                for (int s4 = 0; s4 < 4; ++s4) { Bt = loA[nt][s4] * Bt + loB[nt][s4]; At *= loA[nt][s4]; Bt = hiA[nt][s4] * Bt + hiB[nt][s4]; At *= hiA[nt][s4]; }
                if (h2 == 0) { const int cl = wch * 64 + nt * 32 + l31; SUMS[(wt * 128 + cl) * 2] = At; SUMS[(wt * 128 + cl) * 2 + 1] = Bt; }
            }
            __syncthreads();
            if (!PASS2) {
                if (tid < 128) {
                    float A = 1.f, B = 0.f;
#pragma unroll
                    for (int w = 0; w < 4; ++w) { const float a = SUMS[(w * 128 + tid) * 2], bb = SUMS[(w * 128 + tid) * 2 + 1]; B = a * B + bb; A *= a; }
                    const size_t o = (size_t)(b * 64 + ck) * 1024 + hb * 128 + tid;
                    SUMA[o] = A; SUMB[o] = B;
                }
                __syncthreads();
            } else {
#pragma unroll
                for (int nt = 0; nt < 2; ++nt) {
                    const int cl = wch * 64 + nt * 32 + l31;
                    float H = CAR[cl];
                    for (int w = 0; w < wt; ++w) H = SUMS[(w * 128 + cl) * 2] * H + SUMS[(w * 128 + cl) * 2 + 1];
#pragma unroll
                    for (int s4 = 0; s4 < 4; ++s4) {
                        const float Hlo = loA[nt][s4] * H + loB[nt][s4];
                        float Hs = h2 ? Hlo : H;
                        H = hiA[nt][s4] * Hlo + hiB[nt][s4];
#pragma unroll
                        for (int r4 = 0; r4 < 4; ++r4) {
                            const int r = 4 * s4 + r4;
                            Hs = accA[nt][r] * Hs + accX[nt][r];
                            const float z = bf2f(*(const LAS bf16_t*)(l3 + bzz[nt] + ((r & 3) + 8 * (r >> 2)) * 256));
                            *(LAS bf16_t*)(l3 + bxc[nt] + ((r & 3) + 8 * (r >> 2)) * RS) = (bf16_t)pk2(Hs * z, 0.f);
                        }
                    }
                }
                __syncthreads();
#pragma unroll
                for (int i = 0; i < 4; ++i) {
                    const int tt = i * 32 + (tid >> 4), c16 = tid & 15;
                    const u32x4 v = *(const LAS u32x4*)(l3 + R_XC + tt * RS + c16 * 16);
                    *(u32x4*)(PX + PXS_ZR + hmrow(b, hb, (size_t)(t0 + tt)) + c16 * 8) = v;
                }
                if (tid < 128) {
                    float H = CAR[tid];
#pragma unroll
                    for (int w = 0; w < 4; ++w) H = SUMS[(w * 128 + tid) * 2] * H + SUMS[(w * 128 + tid) * 2 + 1];
                    CAR[tid] = H;
                }
                __syncthreads();
            }
        }
        if (PASS2 && stage == 3 && tid < 128) {
            const size_t o = (size_t)(b * 64 + 11) * 1024 + hb * 128 + tid;
            SUMA[o] = 0.f; SUMB[o] = CAR[tid];
        }
    }
}


typedef short s16x4 __attribute__((ext_vector_type(4)));
DI unsigned off_b(unsigned row, unsigned ch) { return 256u * row + 16u * (ch ^ (((row & 3u) << 2) | ((row >> 2) & 3u))); }
constexpr float AT_THR = 8.0f;
constexpr int AT_KV = 0, AT_LS = 98304, AT_STG = 100352, STG_RS = 144;

template <int MODE> DI void phase_attn(const Params& p, unsigned char* lds, const int wv) {
    LAS unsigned char* l3 = (LAS unsigned char*)lds;
    int tid = TIDX(wv); asm volatile("" : "+v"(tid));
    const int lane = tid & 63, w = wv, l31 = lane & 31, h2 = lane >> 5;
    bf16_t* PX = (bf16_t*)(p.ws + OFF_PX);
    const bf16_t* QH = (const bf16_t*)(p.ws + OFF_QH);
    constexpr size_t SEC_K = (size_t)M * 1024, SEC_V = (size_t)2 * M * 1024;
    bf16_t* O3 = (bf16_t*)p.out; bf16_t* O2 = O3 + (size_t)M * 1024;
    float* LSE3 = (float*)(p.ws + OFF_LSE); float* LSE2 = LSE3 + (size_t)M * 8;
    LAS float* wls = (LAS float*)(l3 + AT_LS) + w * 32;
    const unsigned stg = AT_STG + w * (32 * STG_RS);
    constexpr int NII = (MODE == 0) ? 2 : 1;
    const int total = 64 * 32 * NII;
    const int kk = tid >> 4, c16 = tid & 15;
    const float NEG = -__builtin_inff();
    u32x4 pre[12];
    bf16x8 qf[8];
    int L = blockIdx.x;
    auto decode = [&](int L_, int& b, int& h, int& dil, int& r, int& blk) {
        const int xcd = L_ & 7, idx = (L_ >> 3) & 31, rnd = L_ >> 8;
        const int bh = xcd + 8 * (rnd / NII), ii = rnd % NII;
        b = bh >> 3; h = bh & 7;
        const int set = idx & 1, s16 = idx >> 1;
        if (MODE == 1) { dil = 1; r = 0; blk = set * 16 + s16; }
        else if (s16 < 8) { dil = 16; r = 4 * (s16 >> 1) + 2 * set + (s16 & 1); blk = ii; }
        else { dil = 4; r = 2 * set + (s16 & 1); blk = ii * 4 + ((s16 - 8) >> 1); }
    };
    auto prefetch = [&](size_t sec, int b, int h, int dil, int r, int blk) {
        const bf16_t* base = QH + sec + ((ptrdiff_t)(b * 8 + h) * SEQ + (blk * 256 - 128 + kk) * dil + r) * 128 + c16 * 8;
        const ptrdiff_t tstep = (ptrdiff_t)32 * dil * 128;
#pragma unroll
        for (int i = 0; i < 12; ++i) {
            if (blk > 0 || i >= 4) pre[i] = *(const u32x4*)(base + (ptrdiff_t)i * tstep);
        }
    };
    auto stash = [&]() {
#pragma unroll
        for (int i = 0; i < 12; ++i) *(LAS u32x4*)(l3 + AT_KV + i * 8192 + off_b(kk, c16)) = pre[i];
    };
    auto loadq = [&](bf16x8 (&q)[8], int b, int h, int dil, int r, int blk) {
        const bf16_t* qp = QH + ((size_t)(b * 8 + h) * SEQ + (size_t)(blk * 256 + w * 32 + l31) * dil + r) * 128 + h2 * 8;
#pragma unroll
        for (int ks = 0; ks < 8; ++ks) q[ks] = *(const bf16x8*)(qp + ks * 16);
    };
    unsigned kbase[8];
    { const unsigned xk = ((l31 & 3u) << 2) | ((l31 >> 2) & 3u);
#pragma unroll
      for (int ks = 0; ks < 8; ++ks) kbase[ks] = AT_KV + 256u * l31 + 16u * ((unsigned)(2 * ks + h2) ^ xk); }
    unsigned vbase[4][2];
    { const unsigned blkk = (lane >> 4) & 1u, q4 = (lane & 15u) >> 2, pp = lane & 3u;
#pragma unroll
      for (int d = 0; d < 4; ++d)
#pragma unroll
        for (int t = 0; t < 2; ++t) {
            const unsigned row = 8u * t + 4u * h2 + q4, ch = 4u * d + 2u * blkk + (pp >> 1);
            vbase[d][t] = AT_KV + 256u * row + 16u * (ch ^ ((q4 << 2) | ((2u * t + h2) & 3u))) + 8u * (pp & 1u);
        } }
    if (L < total) { int b, h, dil, r, blk; decode(L, b, h, dil, r, blk); prefetch(SEC_K, b, h, dil, r, blk); }
    for (; L < total; L += gridDim.x) {
        int b, h, dil, r, blk; decode(L, b, h, dil, r, blk);
        loadq(qf, b, h, dil, r, blk);
        stash();
        __syncthreads();
        prefetch(SEC_V, b, h, dil, r, blk);
        float m = -1e30f, lh = 0.f, alpha[5];
        bf16x8 pf[5][2];
        f32x16 Sa, Sb;
#define AT_QK(J, SV) do { \
            _Pragma("unroll") for (int rr = 0; rr < 16; ++rr) SV[rr] = 0.f; \
            bf16x8 kf[8]; \
            _Pragma("unroll") for (int ks = 0; ks < 8; ++ks) kf[ks] = *(const LAS bf16x8*)(l3 + kbase[ks] + (w + (J)) * 8192); \
            __builtin_amdgcn_sched_barrier(0); \
            _Pragma("unroll") for (int ks = 0; ks < 8; ++ks) SV = __builtin_amdgcn_mfma_f32_32x32x16_bf16(kf[ks], qf[ks], SV, 0, 0, 0); \
        } while (0)
#define AT_SMX(J, SV) do { \
            if (blk == 0 && w + (J) < 4) { _Pragma("unroll") for (int rr = 0; rr < 16; ++rr) SV[rr] = NEG; }        \
            if ((J) == 0) { _Pragma("unroll") for (int rr = 0; rr < 16; ++rr) if (crow(rr, h2) < l31) SV[rr] = NEG; }     \
            if ((J) == 4) { _Pragma("unroll") for (int rr = 0; rr < 16; ++rr) if (crow(rr, h2) > l31) SV[rr] = NEG; }     \
            float tm = SV[0]; \
            _Pragma("unroll") for (int rr = 1; rr < 16; ++rr) tm = fmaxf(tm, SV[rr]); \
            tm = half_max(tm); \
            const bool up = tm > m + AT_THR;                 \
            const float mn = up ? tm : m; \
            alpha[J] = up ? __builtin_amdgcn_exp2f(m - mn) : 1.0f; m = mn; \
            float ps = 0.f; \
            _Pragma("unroll") for (int rr = 0; rr < 16; ++rr) { SV[rr] = __builtin_amdgcn_exp2f(SV[rr] - mn); ps += SV[rr]; } \
            lh = lh * alpha[J] + ps; \
            _Pragma("unroll") for (int s = 0; s < 2; ++s) { \
                u32x4 wv; wv.x = pk2(SV[8 * s + 0], SV[8 * s + 1]); wv.y = pk2(SV[8 * s + 2], SV[8 * s + 3]); \
                wv.z = pk2(SV[8 * s + 4], SV[8 * s + 5]); wv.w = pk2(SV[8 * s + 6], SV[8 * s + 7]); \
                pf[J][s] = __builtin_bit_cast(bf16x8, wv); } \
        } while (0)
        AT_QK(0, Sa);
        AT_QK(1, Sb); AT_SMX(0, Sa);
        AT_QK(2, Sa); AT_SMX(1, Sb);
        AT_QK(3, Sb); AT_SMX(2, Sa);
        AT_QK(4, Sa); AT_SMX(3, Sb);
        AT_SMX(4, Sa);
#undef AT_QK
#undef AT_SMX
        const float lt = half_sum(lh);
        const float linv = __builtin_amdgcn_rcpf(lt);
        if (h2 == 0) wls[l31] = m + __builtin_amdgcn_logf(lt);
        __syncthreads();
        stash();
        __syncthreads();
        const int Ln = L + gridDim.x;
        if (Ln < total) { int b2, h2_, dil2, r2, blk2; decode(Ln, b2, h2_, dil2, r2, blk2); prefetch(SEC_K, b2, h2_, dil2, r2, blk2); }
#pragma unroll
        for (int hd = 0; hd < 2; ++hd) {
            f32x16 O[2];
#pragma unroll
            for (int dd = 0; dd < 2; ++dd)
#pragma unroll
                for (int rr = 0; rr < 16; ++rr) O[dd][rr] = 0.f;
#pragma unroll
            for (int j = 0; j < 5; ++j) {
                if (!(blk == 0 && w + j < 4)) {
                    if (!__all(alpha[j] == 1.0f)) {
#pragma unroll
                        for (int dd = 0; dd < 2; ++dd)
#pragma unroll
                            for (int rr = 0; rr < 16; ++rr) O[dd][rr] *= alpha[j];
                    }
                    s16x4 tv[2][2][2];
#pragma unroll
                    for (int s = 0; s < 2; ++s)
#pragma unroll
                        for (int dd = 0; dd < 2; ++dd)
#pragma unroll
                            for (int t = 0; t < 2; ++t)
                                tv[s][dd][t] = __builtin_amdgcn_ds_read_tr16_b64_v4i16((LAS s16x4*)(l3 + vbase[hd * 2 + dd][t] + (w + j) * 8192 + s * 4096));
                    __builtin_amdgcn_sched_barrier(0);
                    __builtin_amdgcn_s_setprio(1);
#pragma unroll
                    for (int s = 0; s < 2; ++s)
#pragma unroll
                        for (int dd = 0; dd < 2; ++dd) {
                            const bf16x8 vf = __builtin_shufflevector(tv[s][dd][0], tv[s][dd][1], 0, 1, 2, 3, 4, 5, 6, 7);
                            O[dd] = __builtin_amdgcn_mfma_f32_32x32x16_bf16(vf, pf[j][s], O[dd], 0, 0, 0);
                        }
                    __builtin_amdgcn_s_setprio(0);
                    __builtin_amdgcn_sched_barrier(0);
                }
            }
#pragma unroll
            for (int dd = 0; dd < 2; ++dd)
#pragma unroll
                for (int g = 0; g < 4; ++g) {
                    u32x2 wv; wv.x = pk2(O[dd][4 * g] * linv, O[dd][4 * g + 1] * linv); wv.y = pk2(O[dd][4 * g + 2] * linv, O[dd][4 * g + 3] * linv);
                    *(LAS u32x2*)(l3 + stg + l31 * STG_RS + (dd * 32 + 8 * g + 4 * h2) * 2) = wv;
                }
            u32x4 mo2[4], mo3[4], mzv[4]; float me2[4], me3[4];
            if (MODE == 1) {
#pragma unroll
                for (int it = 0; it < 4; ++it) {
                    const int q = it * 8 + (lane >> 3), cc = lane & 7;
                    const size_t sq = (size_t)(blk * 256 + w * 32 + q) * dil + r;
                    const size_t ro = hmrow(b, h, sq) + hd * 64 + cc * 8;
                    mo2[it] = __builtin_nontemporal_load((const u32x4*)(O2 + ro));
                    mo3[it] = __builtin_nontemporal_load((const u32x4*)(O3 + ro));
                    mzv[it] = __builtin_nontemporal_load((const u32x4*)(PX + PXS_ZA + ro));
                    me2[it] = LSE2[(size_t)(b * 8 + h) * SEQ + sq]; me3[it] = LSE3[(size_t)(b * 8 + h) * SEQ + sq];
                }
                __builtin_amdgcn_sched_barrier(0);
            }
#pragma unroll
            for (int it = 0; it < 4; ++it) {
                const int q = it * 8 + (lane >> 3), cc = lane & 7;
                const u32x4 o1 = *(const LAS u32x4*)(l3 + stg + q * STG_RS + cc * 16);
                const size_t sq = (size_t)(blk * 256 + w * 32 + q) * dil + r, tok = (size_t)b * SEQ + sq;
                const int col = h * 128 + hd * 64 + cc * 8;
                if (MODE == 0) {
                    bf16_t* Ob = (dil == 16) ? O3 : O2;
                    *(u32x4*)(Ob + hmrow(b, h, sq) + hd * 64 + cc * 8) = o1;
                } else {
                    const u32x4 o2 = mo2[it], o3 = mo3[it], zv = mzv[it];
                    bf16_t* zp = PX + PXS_ZA + hmrow(b, h, sq) + hd * 64 + cc * 8;
                    const float e1 = wls[q], e2 = me2[it], e3 = me3[it];
                    const float em = fmaxf(e1, fmaxf(e2, e3));
                    float w1 = __builtin_amdgcn_exp2f(e1 - em), w2 = __builtin_amdgcn_exp2f(e2 - em), w3 = __builtin_amdgcn_exp2f(e3 - em);
                    const float wn = __builtin_amdgcn_rcpf(w1 + w2 + w3); w1 *= wn; w2 *= wn; w3 *= wn;
                    u32x4 res;
#pragma unroll
                    for (int e = 0; e < 4; ++e) {
                        const float a0 = w1 * bflo(o1[e]) + w2 * bflo(o2[e]) + w3 * bflo(o3[e]);
                        const float a1 = w1 * bfhi(o1[e]) + w2 * bfhi(o2[e]) + w3 * bfhi(o3[e]);
                        res[e] = pk2(a0 * bflo(zv[e]), a1 * bfhi(zv[e]));
                    }
                    *(u32x4*)zp = res;
                }
            }
        }
        if (MODE == 0) {
            if (h2 == 0) {
                const size_t sq = (size_t)(blk * 256 + w * 32 + l31) * dil + r;
                float* Lb = (dil == 16) ? LSE3 : LSE2;
                Lb[(size_t)(b * 8 + h) * SEQ + sq] = m + __builtin_amdgcn_logf(lt);
            }
        }
        __syncthreads();
    }
}

#define XB_TMO      128
#define XB_XCNT(j)  (256  + 64 * (j))
#define XB_XSUB(j)  (1280 + 64 * (j))
#define XB_XGEN(j)  (2304 + 64 * (j))
#define XB_TOP      3328
#define XB_TOPGEN   3392
#define XCD_BAR_WORDS 3456
#define XB_SPIN_CAP (1u << 22)
DI unsigned xb_ld(unsigned* p)              { return __hip_atomic_load(p, __ATOMIC_RELAXED, __HIP_MEMORY_SCOPE_AGENT); }
DI unsigned xb_add(unsigned* p, unsigned v) { return __hip_atomic_fetch_add(p, v, __ATOMIC_RELAXED, __HIP_MEMORY_SCOPE_AGENT); }
DI unsigned xb_xcc_id() { return (unsigned)__builtin_amdgcn_s_getreg((3 << 11) | 20) & 0xFu; }
#define XB_SPIN(cond, bar) do { unsigned _sp = 0; while (cond) { __builtin_amdgcn_s_sleep(1); \
    if ((++_sp & 255u) == 0u) { if (xb_ld(&(bar)[XB_TMO])) break; if (_sp > XB_SPIN_CAP) { atomicAdd(&(bar)[XB_TMO], 1u); break; } } } } while (0)
struct XcdBarrier { unsigned* bar; unsigned x; volatile LAS unsigned* st; int wv; };
DI XcdBarrier xcd_barrier_post(unsigned* bar, volatile LAS unsigned* st, const int wv) {
    XcdBarrier b; b.bar = bar; b.x = xb_xcc_id(); b.st = st; b.wv = wv;
    if (TIDX(wv) == 0) (void)xb_add(&bar[XB_XCNT(b.x)], 1u);
    return b;
}
DI void xcd_barrier_complete(unsigned* bar, unsigned x, unsigned& nloc, unsigned& nx) {
    const unsigned G = gridDim.x * gridDim.y * gridDim.z;
    unsigned sum, cnt, mine, sp = 0u;
    for (;;) {
        sum = 0u; cnt = 0u; mine = 0u;
#pragma unroll
        for (unsigned j = 0; j < 16; ++j) { const unsigned c = xb_ld(&bar[XB_XCNT(j)]); sum += c; cnt += (c > 0u) ? 1u : 0u; mine = (j == x) ? c : mine; }
        if (sum == G) break;
        __builtin_amdgcn_s_sleep(1);
        if ((++sp & 255u) == 0u) { if (xb_ld(&bar[XB_TMO])) break; if (sp > XB_SPIN_CAP) { atomicAdd(&bar[XB_TMO], 1u); break; } }
    }
    nloc = mine > 0u ? mine : 1u; nx = cnt > 0u ? cnt : 1u;
}
DI void xcd_barrier(const XcdBarrier& b) {
    asm volatile("s_waitcnt vmcnt(0)" ::: "memory");
    __syncthreads();
    if (TIDX(b.wv) == 0) {
        unsigned* bar = b.bar;
        __builtin_amdgcn_s_waitcnt(0);
        unsigned nloc = b.st[0], nx = b.st[1];
        if (nloc == 0u) { xcd_barrier_complete(bar, b.x, nloc, nx); b.st[0] = nloc; b.st[1] = nx; }
        const unsigned old = xb_add(&bar[XB_XSUB(b.x)], 1u);
        const unsigned gen = old / nloc;
        if (old + 1u == (gen + 1u) * nloc) {
            __builtin_amdgcn_fence(__ATOMIC_RELEASE, "agent");
            asm volatile("s_waitcnt vmcnt(0)" ::: "memory");
            const unsigned og = xb_add(&bar[XB_TOP], 1u);
            const unsigned tg = og / nx;
            if (og + 1u == (tg + 1u) * nx) xb_add(&bar[XB_TOPGEN], 1u);
            else XB_SPIN(xb_ld(&bar[XB_TOPGEN]) == tg, bar);
            __builtin_amdgcn_fence(__ATOMIC_ACQUIRE, "agent");
            xb_add(&bar[XB_XGEN(b.x)], 1u);
            asm volatile("s_waitcnt vmcnt(0)" ::: "memory");
        } else {
            XB_SPIN(xb_ld(&bar[XB_XGEN(b.x)]) == gen, bar);
            __builtin_amdgcn_fence(__ATOMIC_ACQUIRE, "agent");
            asm volatile("s_waitcnt vmcnt(0)" ::: "memory");
        }
    }
    __syncthreads();
}

constexpr int N_PHASES = 8;
__global__ void __launch_bounds__(512) mega(Params p) {
    extern __shared__ __attribute__((aligned(16))) unsigned char lds[];
    LAS unsigned char* l3 = (LAS unsigned char*)lds;
    float* smf = (float*)lds;
    const int G = gridDim.x, c = blockIdx.x;
    bf16_t* PX = (bf16_t*)(p.ws + OFF_PX); bf16_t* QH = (bf16_t*)(p.ws + OFF_QH); bf16_t* KH = (bf16_t*)(p.ws + OFF_KH);
    const int lo = p.ph_lo, hi = p.ph_hi;
    volatile LAS unsigned* xst = (volatile LAS unsigned*)(l3 + LDS_BYTES - 16);
    const int wv = __builtin_amdgcn_readfirstlane((int)threadIdx.x >> 6);
    if (TIDX(wv) == 0) { xst[0] = 0u; xst[1] = 0u; }
    __syncthreads();
    XcdBarrier xbar = xcd_barrier_post((unsigned*)(p.ws + OFF_BAR), xst, wv);
#define IN(k) (lo <= (k) && (k) < hi)
#define SYNC(k) do { if (IN(k) && IN((k) + 1)) xcd_barrier(xbar); } while (0)
    if (IN(0)) phase_prologue(p, smf, wv);
    if (IN(0) && IN(1)) {
        __syncthreads();
        if (TIDX(wv) == 0) {
            unsigned* mc = (unsigned*)(p.ws + OFF_BAR) + MOD_CNT_WORD; unsigned spins = 0;
            while (__hip_atomic_load(mc, __ATOMIC_RELAXED, __HIP_MEMORY_SCOPE_AGENT) < 192u) { __builtin_amdgcn_s_sleep(2); if (++spins > (1u << 24)) break; }
            __builtin_amdgcn_fence(__ATOMIC_ACQUIRE, "agent");
            asm volatile("s_waitcnt vmcnt(0)" ::: "memory");
        }
        __syncthreads();
    }
    if (IN(1)) phase_h(p, wv);
    SYNC(1);
    if (IN(2)) {
        pg8::TileSched S; S.init(M, NP, G, c, 1, p.ws + OFF_H, nullptr, (size_t)256 * D * 2, 0, p.ws + OFF_WINT, nullptr, 1024);
        EpiProj E{PX, QH, (const float*)(p.ws + OFF_ROPE), l3 + 131072, -1};
        pg8::gemm_phase<EpiProj, pg8::TileSched, true, true>(l3, D, 1024, 16, S, E, wv, 128, 256);
    }
    SYNC(2);
    if (IN(3)) { if ((blockIdx.x >> 3) & 1) { phase_attn<0>(p, lds, wv); phase_rnn<true>(p, lds, wv, 3); phase_rnn<false>(p, lds, wv, 3); } else { phase_rnn<true>(p, lds, wv, 3); phase_rnn<false>(p, lds, wv, 3); phase_attn<0>(p, lds, wv); } }
    SYNC(3);
    if (IN(4)) { if ((blockIdx.x >> 3) & 1) { phase_attn<1>(p, lds, wv); phase_rnn<true>(p, lds, wv, 4); } else { phase_rnn<true>(p, lds, wv, 4); phase_attn<1>(p, lds, wv); } }
    SYNC(4);
    if (IN(5)) {
        pg8::TileSched S; S.init(M, 2048, G, c, 1, p.ws + OFF_H, nullptr, (size_t)256 * D * 2, 0, p.ws + OFF_WGL, nullptr, 1024);
        EpiGate E{KH, p.b_gate, l3 + 131072};
        pg8::gemm_phase<EpiGate, pg8::TileSched, true, true>(l3, D, 1024, 16, S, E, wv, 128, 256);
    }
    SYNC(5);
    if (IN(6)) {
        pg8::TileSched S; S.init(M, 1024, G, c, 2, PX + PXS_ZR, PX + PXS_ZA, 0, 1, p.ws + OFF_WR, p.ws + OFF_WA, 1024);
        EpiMerged E{QH};
        pg8::gemm_phase<EpiMerged, pg8::TileSched, true, true>(l3, 128, 1024, 16, S, E, wv, 128, (size_t)SEQ * 256);
    }
    SYNC(6);
    if (IN(7)) {
        pg8::TileSched S; S.init(M, 1024, G, c, 1, QH, nullptr, (size_t)256 * 1024 * 2, 0, p.ws + OFF_WO, nullptr, 1024);
        EpiOut E{p.x, (const float*)(p.ws + OFF_MOD), p.g_final, p.out, (float*)(p.ws + OFF_ROWSQ), (unsigned*)(p.ws + OFF_BAR + 16384), l3 + 131072};
        pg8::gemm_phase<EpiOut, pg8::TileSched, true, true>(l3, 64, 1024, 16, S, E, wv, 32768, 65536);
    }
#undef IN
#undef SYNC
}

extern "C" void kernel_launch(void* const* d_in, const int* in_sizes, int n_in, void* d_out, int out_size, void* d_ws, size_t ws_size,
                              hipStream_t stream) {
    static int grid_blocks = 0;
    if (grid_blocks == 0) {
        if (ws_size < OFF_END) { fprintf(stderr, "workspace too small: %zu < %zu\n", ws_size, (size_t)OFF_END); grid_blocks = -1; return; }
        int dev = 0, cus = 0, per_cu = 0;
        (void)hipGetDevice(&dev);
        (void)hipDeviceGetAttribute(&cus, hipDeviceAttributeMultiprocessorCount, dev);
        (void)hipFuncSetAttribute((const void*)mega, hipFuncAttributeMaxDynamicSharedMemorySize, LDS_BYTES);
        (void)hipOccupancyMaxActiveBlocksPerMultiprocessor(&per_cu, (const void*)mega, 512, LDS_BYTES);
        if (per_cu < 1) { fprintf(stderr, "occupancy query says %d blocks per CU\n", per_cu); per_cu = 1; }
        grid_blocks = cus;
        fprintf(stderr, "mega: cus %d per_cu %d grid %d\n", cus, per_cu, grid_blocks);
    }
    if (grid_blocks < 0) return;
    Params p{};
    p.x = (const float*)d_in[0]; p.c = (const float*)d_in[1]; p.pos = (const int*)d_in[2]; p.g_norm = (const float*)d_in[3];
    p.w_mod = (const float*)d_in[4]; p.b_mod = (const float*)d_in[5]; p.w_in = (const float*)d_in[6]; p.b_gate = (const float*)d_in[7];
    p.conv_w = (const float*)d_in[8]; p.conv_b = (const float*)d_in[9]; p.w_a = (const float*)d_in[10]; p.b_a = (const float*)d_in[11];
    p.w_x = (const float*)d_in[12]; p.b_x = (const float*)d_in[13]; p.lam = (const float*)d_in[14]; p.w_out_rnn = (const float*)d_in[15];
    p.w_out_attn = (const float*)d_in[16]; p.w_o = (const float*)d_in[17]; p.g_final = (const float*)d_in[18];
    p.out = (float*)d_out; p.ws = (char*)d_ws;
    for (int i = 0; i < 16; ++i) p.inv_freq[i] = (float)pow(500000.0, -(double)(2 * i) / 32.0);
    p.ph_lo = 0; p.ph_hi = N_PHASES;
    (void)hipMemsetAsync((char*)d_ws + OFF_BAR, 0, BAR_BYTES, stream);
    void* args[] = {&p};
    hipError_t e = hipLaunchCooperativeKernel((const void*)mega, dim3(grid_blocks), dim3(512), args, LDS_BYTES, stream);
    if (e != hipSuccess) fprintf(stderr, "cooperative launch failed: %s (grid %d)\n", hipGetErrorString(e), grid_blocks);
}
```
